# Optimizing an MI355X kernel written in HIP

```python
import math
import jax, jax.numpy as jnp
from jax import lax
import numpy as np

D_MODEL = 1024
BATCH = 16
SEQ = 256
DEPTH = 2
DEC_BATCH = 8
DEC_SEQ = 2048
PAST_LEN = 256

GRID_W = 64
D_FF = 2816
N_MOD = 9
EPS = 1e-6
N_DIR = 2
CONV_W = 4
CHUNK = 64
SSM_HEADS = 8
SSM_HEAD_DIM = 64
SSM_INNER = SSM_HEADS * SSM_HEAD_DIM
SSM_GROUPS = 2
SSM_STATE = 64
SSM_CONV_DIM = SSM_INNER + 2 * SSM_GROUPS * SSM_STATE
ATTN_HEADS = 8
KV_HEADS = 2
HEAD_DIM = 64
ATTN_INNER = ATTN_HEADS * HEAD_DIM
ROPE_THETA = 10000.0
Q_BLOCK = 128
DN_HEADS = 8
DN_HEAD_DIM = 64
DN_INNER = DN_HEADS * DN_HEAD_DIM
LRU_BLOCKS = 8
LRU_BLOCK_DIM = 64
LRU_WIDTH = LRU_BLOCKS * LRU_BLOCK_DIM
LRU_C = 8.0
N_BRANCH = 4
BRANCH_W = 512
IN_SIZES = (SSM_INNER, SSM_CONV_DIM, N_DIR * SSM_HEADS,
            ATTN_INNER, KV_HEADS * HEAD_DIM, KV_HEADS * HEAD_DIM,
            DN_INNER, DN_INNER, DN_INNER, N_DIR * DN_HEADS, N_DIR * DN_HEADS, DN_INNER,
            LRU_WIDTH, LRU_WIDTH,
            N_BRANCH * D_MODEL)
N_IN = sum(IN_SIZES)

kernel_name = 'hybrid_prefix_diffusion_step'


def _rms_norm(x, g):
    xf = x.astype(jnp.float32)
    y = xf * lax.rsqrt(jnp.mean(xf * xf, axis=-1, keepdims=True) + EPS)
    return (y * g.astype(jnp.float32)).astype(x.dtype)


def _l2_norm(x):
    xf = x.astype(jnp.float32)
    return xf * lax.rsqrt(jnp.sum(xf * xf, axis=-1, keepdims=True) + EPS)


def _rev(z):
    return jnp.flip(z, axis=1)


def _adaln(cvec, w, b):
    return (jax.nn.silu(cvec) @ w + b).reshape(cvec.shape[0], N_MOD, D_MODEL)


def _swiglu(x, w13, w2):
    g, u = jnp.split(x @ w13, 2, axis=-1)
    return (jax.nn.silu(g) * u) @ w2


def _depthwise_conv(x, w, b):
    t = x.shape[1]
    lp = CONV_W // 2
    xp = jnp.pad(x, ((0, 0), (lp, CONV_W - 1 - lp), (0, 0)))
    out = b
    for j in range(CONV_W):
        out = out + w[j] * xp[:, j:j + t]
    return out


def _axial_rope(rows):
    n_freq = HEAD_DIM // 4
    inv = ROPE_THETA ** (-jnp.arange(n_freq, dtype=jnp.float32) / n_freq)
    row = jnp.repeat(jnp.arange(rows, dtype=jnp.float32), GRID_W)
    col = jnp.tile(jnp.arange(GRID_W, dtype=jnp.float32), rows)
    ang = jnp.stack([row[:, None] * inv, col[:, None] * inv], axis=1)
    return jnp.cos(ang), jnp.sin(ang)


def _apply_rope(x, cos, sin):
    b, t, h, d = x.shape
    xr = x.astype(jnp.float32).reshape(b, t, h, 2, 2, d // 4)
    x1, x2 = xr[..., 0, :], xr[..., 1, :]
    c = cos[None, :, None]
    s = sin[None, :, None]
    y = jnp.stack([x1 * c - x2 * s, x1 * s + x2 * c], axis=-2)
    return y.reshape(b, t, h, d).astype(x.dtype)


def _block_attention(q, k, v):
    b, t, h, d = q.shape
    g = h // KV_HEADS
    nb = t // Q_BLOCK
    qb = jnp.moveaxis(q.astype(jnp.float32).reshape(b, nb, Q_BLOCK, KV_HEADS, g, d), 1, 0)
    kf = k.astype(jnp.float32)
    vf = v.astype(jnp.float32)
    scale = d ** -0.5

    def attend(qblk):
        s = jnp.einsum('bqkgd,bskd->bkgqs', qblk, kf) * scale
        pr = jax.nn.softmax(s, axis=-1)
        return jnp.einsum('bkgqs,bskd->bqkgd', pr, vf)

    o = lax.map(attend, qb)
    return jnp.moveaxis(o, 0, 1).reshape(b, t, h, d)


def _ssd_scan(x, dt, a, bm, cm, h0):
    bsz, t, nh, hp = x.shape
    ns = bm.shape[-1]
    nc = t // CHUNK
    xc = x.astype(jnp.float32).reshape(bsz, nc, CHUNK, nh, hp)
    dtc = dt.astype(jnp.float32).reshape(bsz, nc, CHUNK, nh)
    bc = bm.astype(jnp.float32).reshape(bsz, nc, CHUNK, nh, ns)
    cc = cm.astype(jnp.float32).reshape(bsz, nc, CHUNK, nh, ns)
    acum = jnp.cumsum(dtc * a.astype(jnp.float32), axis=2)
    mask = jnp.tril(jnp.ones((CHUNK, CHUNK), dtype=bool))[None, None, :, :, None]
    seg = acum[:, :, :, None, :] - acum[:, :, None, :, :]
    decay = jnp.exp(jnp.where(mask, seg, -jnp.inf))
    scores = jnp.einsum('bcihn,bcjhn->bcijh', cc, bc) * decay * dtc[:, :, None, :, :]
    y_intra = jnp.einsum('bcijh,bcjhp->bcihp', scores, xc)
    w_end = jnp.exp(acum[:, :, -1:, :] - acum) * dtc
    chunk_states = jnp.einsum('bcjh,bcjhn,bcjhp->bchpn', w_end, bc, xc)
    chunk_decay = jnp.exp(acum[:, :, -1, :])

    def step(h, inp):
        s, d = inp
        return d[:, :, None, None] * h + s, h

    h_last, h_prev = lax.scan(step, h0.astype(jnp.float32),
                              (jnp.moveaxis(chunk_states, 1, 0), jnp.moveaxis(chunk_decay, 1, 0)))
    h_prev = jnp.moveaxis(h_prev, 0, 1)
    y_inter = jnp.einsum('bcihn,bchpn->bcihp', cc, h_prev) * jnp.exp(acum)[..., None]
    return (y_intra + y_inter).reshape(bsz, t, nh, hp), h_last


def _delta_scan(q, k, v, g, beta, s0):
    bsz, t, nh, dk = q.shape
    dv = v.shape[-1]
    nc = t // CHUNK

    def chunks(z):
        z = jnp.moveaxis(z.astype(jnp.float32), 2, 1)
        return z.reshape(bsz, nh, nc, CHUNK, *z.shape[3:])

    q = chunks(q) * dk ** -0.5
    k = chunks(k)
    v = chunks(v)
    g = chunks(g)
    beta = chunks(beta)
    gc = jnp.cumsum(g, axis=-1)
    incl = jnp.tril(jnp.ones((CHUNK, CHUNK), dtype=bool))
    strict = jnp.tril(jnp.ones((CHUNK, CHUNK), dtype=bool), k=-1)
    decay = jnp.exp(jnp.where(incl, gc[..., :, None] - gc[..., None, :], -jnp.inf))
    kb = k * beta[..., None]
    m = jnp.where(strict, jnp.einsum('bhcik,bhcjk->bhcij', kb, k) * decay, 0.0)
    eye = jnp.eye(CHUNK, dtype=jnp.float32)
    rhs = jnp.concatenate([v * beta[..., None], kb * jnp.exp(gc)[..., None]], axis=-1)
    sol = lax.linalg.triangular_solve(m + eye, rhs, left_side=True, lower=True, unit_diagonal=True)
    u, w = sol[..., :dv], sol[..., dv:]
    qk = jnp.where(incl, jnp.einsum('bhcik,bhcjk->bhcij', q, k) * decay, 0.0)
    qg = q * jnp.exp(gc)[..., None]
    kdec = k * jnp.exp(gc[..., -1:] - gc)[..., None]
    gl = jnp.exp(gc[..., -1])

    def step(s, inp):
        u_c, w_c, qk_c, qg_c, kd_c, gl_c = inp
        v_new = u_c - jnp.einsum('bhik,bhkv->bhiv', w_c, s)
        o = jnp.einsum('bhik,bhkv->bhiv', qg_c, s) + jnp.einsum('bhij,bhjv->bhiv', qk_c, v_new)
        s = s * gl_c[..., None, None] + jnp.einsum('bhjk,bhjv->bhkv', kd_c, v_new)
        return s, o

    xs = (jnp.moveaxis(u, 2, 0), jnp.moveaxis(w, 2, 0), jnp.moveaxis(qk, 2, 0),
          jnp.moveaxis(qg, 2, 0), jnp.moveaxis(kdec, 2, 0), jnp.moveaxis(gl, 2, 0))
    s_last, o = lax.scan(step, s0.astype(jnp.float32), xs)
    o = jnp.moveaxis(o, 0, 2).reshape(bsz, nh, t, dv)
    return jnp.moveaxis(o, 1, 2), s_last


def _linear_scan(a, b, h0):
    def comb(l, r):
        return (l[0] * r[0], r[0] * l[1] + r[1])

    acum, bcum = lax.associative_scan(comb, (a, b), axis=1)
    h = acum * h0.astype(jnp.float32)[:, None] + bcum
    return h, h[:, -1]


def _token_mix(xn, p, rope, ctx):
    bsz, t, _ = xn.shape
    f32 = jnp.float32
    proj = xn @ p['w_in']
    splits = np.cumsum(IN_SIZES)[:-1]
    (z_a, xbc_a, dt_a, q_b, k_b, v_b, q_c, k_c, v_c, beta_c, a_c, gate_c,
     x_d, y_d, gate_raw) = jnp.split(proj, splits, axis=-1)
    if ctx is None:
        ssm_f = jnp.zeros((bsz, SSM_HEADS, SSM_HEAD_DIM, SSM_STATE), f32)
        ssm_b = ssm_f
        dn_f = jnp.zeros((bsz, DN_HEADS, DN_HEAD_DIM, DN_HEAD_DIM), f32)
        dn_b = dn_f
        lru_f = jnp.zeros((bsz, LRU_WIDTH), f32)
        lru_b = lru_f
    else:
        ck, cv, ssm_f, ssm_b, dn_f, dn_b, lru_f, lru_b = ctx

    xbc = jax.nn.silu(_depthwise_conv(xbc_a, p['ssm_conv_w'], p['ssm_conv_b']))
    rep = SSM_HEADS // SSM_GROUPS
    xs = xbc[..., :SSM_INNER].reshape(bsz, t, SSM_HEADS, SSM_HEAD_DIM)
    gn = SSM_GROUPS * SSM_STATE
    bm = jnp.repeat(xbc[..., SSM_INNER:SSM_INNER + gn].reshape(bsz, t, SSM_GROUPS, SSM_STATE), rep, axis=2)
    cm = jnp.repeat(xbc[..., SSM_INNER + gn:].reshape(bsz, t, SSM_GROUPS, SSM_STATE), rep, axis=2)
    dt = jax.nn.softplus(dt_a.reshape(bsz, t, N_DIR, SSM_HEADS).astype(f32) + p['ssm_dt_bias'])
    a_ssm = -jnp.exp(p['ssm_a_log'].astype(f32))
    y_f, ssm_f_new = _ssd_scan(xs, dt[:, :, 0], a_ssm[0], bm, cm, ssm_f)
    y_bk, ssm_b_new = _ssd_scan(_rev(xs), _rev(dt[:, :, 1]), a_ssm[1], _rev(bm), _rev(cm), ssm_b)
    y = y_f + _rev(y_bk) + p['ssm_d'].astype(f32)[:, None] * xs
    o_a = _rms_norm(y.reshape(bsz, t, SSM_INNER) * jax.nn.silu(z_a.astype(f32)), p['ssm_norm'])

    q = _rms_norm(q_b.reshape(bsz, t, ATTN_HEADS, HEAD_DIM), p['attn_q_norm'])
    k = _rms_norm(k_b.reshape(bsz, t, KV_HEADS, HEAD_DIM), p['attn_k_norm'])
    v = v_b.reshape(bsz, t, KV_HEADS, HEAD_DIM)
    if ctx is None:
        o_b = _block_attention(q, k, v)
    else:
        cos, sin = rope
        q = _apply_rope(q, cos, sin)
        k_lat = _apply_rope(k, cos, sin)
        k_all = jnp.concatenate([ck.astype(k_lat.dtype), k_lat], axis=1)
        v_all = jnp.concatenate([cv.astype(v.dtype), v], axis=1)
        o_b = _block_attention(q, k_all, v_all)
    o_b = o_b.reshape(bsz, t, ATTN_INNER)

    qkv = jax.nn.silu(_depthwise_conv(jnp.concatenate([q_c, k_c, v_c], axis=-1), p['dn_conv_w'], p['dn_conv_b']))
    qd = _l2_norm(qkv[..., :DN_INNER].reshape(bsz, t, DN_HEADS, DN_HEAD_DIM))
    kd = _l2_norm(qkv[..., DN_INNER:2 * DN_INNER].reshape(bsz, t, DN_HEADS, DN_HEAD_DIM))
    vd = qkv[..., 2 * DN_INNER:].reshape(bsz, t, DN_HEADS, DN_HEAD_DIM)
    beta = jax.nn.sigmoid(beta_c.reshape(bsz, t, N_DIR, DN_HEADS).astype(f32))
    gdec = -jnp.exp(p['dn_a_log'].astype(f32)) * jax.nn.softplus(
        a_c.reshape(bsz, t, N_DIR, DN_HEADS).astype(f32) + p['dn_dt_bias'])
    o_f, dn_f_new = _delta_scan(qd, kd, vd, gdec[:, :, 0], beta[:, :, 0], dn_f)
    o_bk, dn_b_new = _delta_scan(_rev(qd), _rev(kd), _rev(vd), _rev(gdec[:, :, 1]), _rev(beta[:, :, 1]), dn_b)
    o_c = _rms_norm(o_f + _rev(o_bk), p['dn_norm']) * jax.nn.silu(
        gate_c.reshape(bsz, t, DN_HEADS, DN_HEAD_DIM).astype(f32))
    o_c = o_c.reshape(bsz, t, DN_INNER)

    xl = _depthwise_conv(x_d, p['lru_conv_w'], p['lru_conv_b']).astype(f32)
    xb = xl.reshape(bsz, t, LRU_BLOCKS, LRU_BLOCK_DIM)
    r = jax.nn.sigmoid(jnp.einsum('btkd,nkde->btnke', xb, p['lru_w_a'].astype(f32)).reshape(
        bsz, t, N_DIR, LRU_WIDTH) + p['lru_b_a'])
    ig = jax.nn.sigmoid(jnp.einsum('btkd,nkde->btnke', xb, p['lru_w_i'].astype(f32)).reshape(
        bsz, t, N_DIR, LRU_WIDTH) + p['lru_b_i'])
    log_a = -LRU_C * r * jax.nn.softplus(-p['lru_lambda'].astype(f32))
    a_l = jnp.exp(log_a)
    u_l = jnp.sqrt(-jnp.expm1(2.0 * log_a)) * ig * xl[:, :, None, :]
    h_f, lru_f_new = _linear_scan(a_l[:, :, 0], u_l[:, :, 0], lru_f)
    h_bk, lru_b_new = _linear_scan(_rev(a_l[:, :, 1]), _rev(u_l[:, :, 1]), lru_b)
    o_d = (h_f + _rev(h_bk)) * jax.nn.gelu(y_d.astype(f32))

    gates = jax.nn.sigmoid(gate_raw.reshape(bsz, t, N_BRANCH, D_MODEL))
    branches = (o_a, o_b, o_c, o_d)
    merged = gates[:, :, 0] * (branches[0].astype(xn.dtype) @ p['w_branch'][0])
    for n in range(1, N_BRANCH):
        merged = merged + gates[:, :, n] * (branches[n].astype(xn.dtype) @ p['w_branch'][n])
    out = (merged @ p['w_out']).astype(xn.dtype)
    if ctx is None:
        return out, (k, v, ssm_f_new, ssm_b_new, dn_f_new, dn_b_new, lru_f_new, lru_b_new)
    return out, None


def _trunk_layer(h, mod, p, rope, ctx):
    mod = mod.astype(h.dtype)
    m = [mod[:, i][:, None, :] for i in range(N_MOD)]
    xn = _rms_norm(h, p['norm_ffn1']) * (1.0 + m[1]) + m[0]
    h = h + 0.5 * m[2] * _swiglu(xn, p['ffn1_w13'], p['ffn1_w2'])
    xn = _rms_norm(h, p['norm_mix']) * (1.0 + m[4]) + m[3]
    mix, new_ctx = _token_mix(xn, p, rope, ctx)
    h = h + m[5] * mix
    xn = _rms_norm(h, p['norm_ffn2']) * (1.0 + m[7]) + m[6]
    h = h + 0.5 * m[8] * _swiglu(xn, p['ffn2_w13'], p['ffn2_w2'])
    return h, new_ctx


def setup_inputs(seed: int = 0) -> dict:
    key = jax.random.key(seed)
    keys = iter(jax.random.split(key, 64))
    f32 = jnp.float32

    def nrm(shape, scale):
        return scale * jax.random.normal(next(keys), shape, f32)

    def gain(shape):
        return 1.0 + nrm(shape, 0.01)

    def unif(shape, lo, hi):
        return jax.random.uniform(next(keys), shape, f32, lo, hi)

    def dt_bias(shape):
        dt0 = jnp.exp(unif(shape, math.log(1e-3), math.log(1e-1)))
        return dt0 + jnp.log(-jnp.expm1(-dt0))

    a_base = unif((DEPTH, N_DIR, LRU_WIDTH), 0.9, 0.999) ** (1.0 / LRU_C)
    lru_lambda = jnp.log(a_base) - jnp.log1p(-a_base)
    return {
        'x_prompt': nrm((BATCH, SEQ, D_MODEL), 1.0),
        'x_sample': nrm((DEC_BATCH, DEC_SEQ, D_MODEL), 1.0),
        'cache_k': nrm((DEC_BATCH, DEPTH, PAST_LEN, KV_HEADS, HEAD_DIM), 1.0),
        'cache_v': nrm((DEC_BATCH, DEPTH, PAST_LEN, KV_HEADS, HEAD_DIM), 1.0),
        'state_ssm': nrm((DEC_BATCH, DEPTH, N_DIR, SSM_HEADS, SSM_HEAD_DIM, SSM_STATE), 0.3),
        'state_delta': nrm((DEC_BATCH, DEPTH, N_DIR, DN_HEADS, DN_HEAD_DIM, DN_HEAD_DIM), 0.1),
        'state_lru': nrm((DEC_BATCH, DEPTH, N_DIR, LRU_WIDTH), 0.5),
        'c': nrm((DEC_BATCH, D_MODEL), 1.0),
        'c_ctx': nrm((D_MODEL,), 1.0),
        'w_ada': nrm((DEPTH, D_MODEL, N_MOD * D_MODEL), 0.5 * D_MODEL ** -0.5),
        'b_ada': nrm((DEPTH, N_MOD * D_MODEL), 0.01),
        'norm_ffn1': gain((DEPTH, D_MODEL)),
        'ffn1_w13': nrm((DEPTH, D_MODEL, 2 * D_FF), D_MODEL ** -0.5),
        'ffn1_w2': nrm((DEPTH, D_FF, D_MODEL), D_FF ** -0.5),
        'norm_mix': gain((DEPTH, D_MODEL)),
        'w_in': nrm((DEPTH, D_MODEL, N_IN), D_MODEL ** -0.5),
        'ssm_conv_w': nrm((DEPTH, CONV_W, SSM_CONV_DIM), 0.5),
        'ssm_conv_b': nrm((DEPTH, SSM_CONV_DIM), 0.01),
        'ssm_a_log': jnp.log(unif((DEPTH, N_DIR, SSM_HEADS), 1.0, 16.0)),
        'ssm_dt_bias': dt_bias((DEPTH, N_DIR, SSM_HEADS)),
        'ssm_d': gain((DEPTH, SSM_HEADS)),
        'ssm_norm': gain((DEPTH, SSM_INNER)),
        'attn_q_norm': gain((DEPTH, HEAD_DIM)),
        'attn_k_norm': gain((DEPTH, HEAD_DIM)),
        'dn_conv_w': nrm((DEPTH, CONV_W, 3 * DN_INNER), 0.5),
        'dn_conv_b': nrm((DEPTH, 3 * DN_INNER), 0.01),
        'dn_a_log': jnp.log(unif((DEPTH, N_DIR, DN_HEADS), 1.0, 16.0)),
        'dn_dt_bias': dt_bias((DEPTH, N_DIR, DN_HEADS)),
        'dn_norm': gain((DEPTH, DN_HEAD_DIM)),
        'lru_conv_w': nrm((DEPTH, CONV_W, LRU_WIDTH), 0.5),
        'lru_conv_b': nrm((DEPTH, LRU_WIDTH), 0.01),
        'lru_w_a': nrm((DEPTH, N_DIR, LRU_BLOCKS, LRU_BLOCK_DIM, LRU_BLOCK_DIM), LRU_BLOCK_DIM ** -0.5),
        'lru_b_a': nrm((DEPTH, N_DIR, LRU_WIDTH), 0.01),
        'lru_w_i': nrm((DEPTH, N_DIR, LRU_BLOCKS, LRU_BLOCK_DIM, LRU_BLOCK_DIM), LRU_BLOCK_DIM ** -0.5),
        'lru_b_i': nrm((DEPTH, N_DIR, LRU_WIDTH), 0.01),
        'lru_lambda': lru_lambda,
        'w_branch': nrm((DEPTH, N_BRANCH, BRANCH_W, D_MODEL), BRANCH_W ** -0.5),
        'w_out': nrm((DEPTH, D_MODEL, D_MODEL), D_MODEL ** -0.5),
        'norm_ffn2': gain((DEPTH, D_MODEL)),
        'ffn2_w13': nrm((DEPTH, D_MODEL, 2 * D_FF), D_MODEL ** -0.5),
        'ffn2_w2': nrm((DEPTH, D_FF, D_MODEL), D_FF ** -0.5),
        'final_norm': gain((D_MODEL,)),
    }


def reference(x_prompt, x_sample, cache_k, cache_v, state_ssm, state_delta, state_lru, c, c_ctx,
              w_ada, b_ada, norm_ffn1, ffn1_w13, ffn1_w2, norm_mix, w_in,
              ssm_conv_w, ssm_conv_b, ssm_a_log, ssm_dt_bias, ssm_d, ssm_norm,
              attn_q_norm, attn_k_norm,
              dn_conv_w, dn_conv_b, dn_a_log, dn_dt_bias, dn_norm,
              lru_conv_w, lru_conv_b, lru_w_a, lru_b_a, lru_w_i, lru_b_i, lru_lambda,
              w_branch, w_out, norm_ffn2, ffn2_w13, ffn2_w2, final_norm):
    rows = x_sample.shape[1] // GRID_W
    rope = _axial_rope(rows)
    hp = x_prompt
    hs = x_sample
    ks, vs, ssm_s, dn_s, lru_s = [], [], [], [], []
    for l in range(DEPTH):
        p = {
            'norm_ffn1': norm_ffn1[l], 'ffn1_w13': ffn1_w13[l], 'ffn1_w2': ffn1_w2[l],
            'norm_mix': norm_mix[l], 'w_in': w_in[l],
            'ssm_conv_w': ssm_conv_w[l], 'ssm_conv_b': ssm_conv_b[l], 'ssm_a_log': ssm_a_log[l],
            'ssm_dt_bias': ssm_dt_bias[l], 'ssm_d': ssm_d[l], 'ssm_norm': ssm_norm[l],
            'attn_q_norm': attn_q_norm[l], 'attn_k_norm': attn_k_norm[l],
            'dn_conv_w': dn_conv_w[l], 'dn_conv_b': dn_conv_b[l], 'dn_a_log': dn_a_log[l],
            'dn_dt_bias': dn_dt_bias[l], 'dn_norm': dn_norm[l],
            'lru_conv_w': lru_conv_w[l], 'lru_conv_b': lru_conv_b[l], 'lru_w_a': lru_w_a[l],
            'lru_b_a': lru_b_a[l], 'lru_w_i': lru_w_i[l], 'lru_b_i': lru_b_i[l], 'lru_lambda': lru_lambda[l],
            'w_branch': w_branch[l], 'w_out': w_out[l],
            'norm_ffn2': norm_ffn2[l], 'ffn2_w13': ffn2_w13[l], 'ffn2_w2': ffn2_w2[l],
        }
        mod_ctx = _adaln(c_ctx[None], w_ada[l], b_ada[l])
        mod_lat = _adaln(c, w_ada[l], b_ada[l])
        hp, st = _trunk_layer(hp, mod_ctx, p, None, None)
        k_c, v_c, sf, sb, df, db, lf, lb = st
        ks.append(k_c)
        vs.append(v_c)
        ssm_s.append(jnp.stack([sf, sb], axis=1))
        dn_s.append(jnp.stack([df, db], axis=1))
        lru_s.append(jnp.stack([lf, lb], axis=1))
        ctx_l = (cache_k[:, l], cache_v[:, l], state_ssm[:, l, 0], state_ssm[:, l, 1],
                 state_delta[:, l, 0], state_delta[:, l, 1], state_lru[:, l, 0], state_lru[:, l, 1])
        hs, _ = _trunk_layer(hs, mod_lat, p, rope, ctx_l)
    y_prompt = _rms_norm(hp, final_norm)
    y_sample = _rms_norm(hs, final_norm)
    new_k = jnp.stack(ks, axis=1)
    new_v = jnp.stack(vs, axis=1)
    new_ssm = jnp.stack(ssm_s, axis=1)
    new_delta = jnp.stack(dn_s, axis=1)
    new_lru = jnp.stack(lru_s, axis=1)
    return (y_prompt, y_sample, new_k, new_v, new_ssm, new_delta, new_lru)
```

```cpp
#include <hip/hip_runtime.h>
#include <hip/hip_bf16.h>
#include <hip/hip_cooperative_groups.h>
#include <cstdio>
namespace cg = cooperative_groups;

typedef __attribute__((ext_vector_type(8))) short bf16x8;
typedef __attribute__((ext_vector_type(4))) float f32x4;
typedef unsigned short bfu;

constexpr int NTOK = 20480, NCTX = 4096, DM = 1024, DFF = 2816, NINP = 9264, NPROJ = 5168, LDP = 5376;
#ifndef REP_GEMM
#define REP_GEMM 1
#endif
#ifndef REP_SCAN
#define REP_SCAN 1
#endif
constexpr int NTHREADS = 512;
constexpr int LDS_BYTES = 131072;
constexpr int C_Z = 0, C_XBC = 512, C_DT = 1280, C_QB = 1296, C_KB = 1808, C_VB = 1936, C_QC = 2064,
              C_BETA = 3600, C_AC = 3616, C_GC = 3632, C_XD = 4144, C_YD = 4656;
constexpr int C_MRG = 2064;
constexpr size_t O_NK = 20971520, O_NV = 22020096, O_SSM = 23068672, O_DELTA = 25165824, O_LRU = 27262976;
constexpr size_t WS_W13A = 0;
constexpr size_t WS_W2A = WS_W13A + (size_t)5632 * 1024 * 2;
constexpr size_t WS_WIN = WS_W2A + (size_t)1024 * 2816 * 2;
constexpr size_t WS_WG = WS_WIN + (size_t)LDP * 1024 * 2;
constexpr size_t WS_WBR = WS_WG + (size_t)4096 * 1024 * 2;
constexpr size_t WS_WOUT = WS_WBR + (size_t)4 * 1024 * 512 * 2;
constexpr size_t WS_W13B = WS_WOUT + (size_t)1024 * 1024 * 2;
constexpr size_t WS_W2B = WS_W13B + (size_t)5632 * 1024 * 2;
constexpr size_t WS_XN = WS_W2B + (size_t)1024 * 2816 * 2;
constexpr size_t WS_PROJ = WS_XN + (size_t)NTOK * 1024 * 2;
constexpr size_t WS_BUFY = WS_PROJ + (size_t)NTOK * LDP * 2;
constexpr size_t WS_CTRL = WS_BUFY + (size_t)3 * NTOK * 512 * 2;
constexpr size_t WS_MODS = WS_CTRL + (size_t)NTOK * 48 * 4;
constexpr size_t WS_ROPE = WS_MODS + (size_t)2 * 9 * 9216 * 4;
constexpr size_t WS_CTR = WS_ROPE + (size_t)2 * 64 * 16 * 4;
constexpr size_t WS_XBAR = WS_CTR + 4096;
constexpr size_t WS_END = WS_XBAR + 16384;

enum { I_XP = 0, I_XS, I_CK, I_CV, I_SSSM, I_SDELTA, I_SLRU, I_C, I_CCTX, I_WADA, I_BADA, I_NF1, I_F1W13, I_F1W2,
       I_NMIX, I_WIN, I_SCW, I_SCB, I_SALOG, I_SDTB, I_SD, I_SNORM, I_QN, I_KN, I_DCW, I_DCB, I_DALOG, I_DDTB,
       I_DNORM, I_LCW, I_LCB, I_LWA, I_LBA, I_LWI, I_LBI, I_LLAM, I_WBR, I_WOUT, I_NF2, I_F2W13, I_F2W2, I_FN };

struct Params {
  const float* in[42];
  float* out;
  char* ws;
};

__device__ __forceinline__ int tid_() { int t = threadIdx.x; asm volatile("" : "+v"(t)); return t; }
typedef __bf16 bf16x2_t __attribute__((ext_vector_type(2)));
typedef float f32x2_t __attribute__((ext_vector_type(2)));
__device__ __forceinline__ unsigned pack2(float a, float b) {
  f32x2_t v = {a, b};
  bf16x2_t r = __builtin_convertvector(v, bf16x2_t);
  return __builtin_bit_cast(unsigned, r);
}
__device__ __forceinline__ bfu f2bf(float f) { return (bfu)(pack2(f, 0.f) & 0xffffu); }
__device__ __forceinline__ float bf2f(bfu s) { return __uint_as_float(((unsigned)s) << 16); }
__device__ __forceinline__ void unpack8(const uint4& v, float* f) {
  f[0] = __uint_as_float(v.x << 16); f[1] = __uint_as_float(v.x & 0xffff0000u);
  f[2] = __uint_as_float(v.y << 16); f[3] = __uint_as_float(v.y & 0xffff0000u);
  f[4] = __uint_as_float(v.z << 16); f[5] = __uint_as_float(v.z & 0xffff0000u);
  f[6] = __uint_as_float(v.w << 16); f[7] = __uint_as_float(v.w & 0xffff0000u);
}
__device__ __forceinline__ uint4 pack8(const float* f) {
  uint4 v; v.x = pack2(f[0], f[1]); v.y = pack2(f[2], f[3]); v.z = pack2(f[4], f[5]); v.w = pack2(f[6], f[7]);
  return v;
}
__device__ __forceinline__ float sigmoidf_(float x) { return __builtin_amdgcn_rcpf(1.f + __expf(-x)); }
__device__ __forceinline__ float siluf_(float x) { return x * __builtin_amdgcn_rcpf(1.f + __expf(-x)); }
__device__ __forceinline__ float softplusf_(float x) { return fmaxf(x, 0.f) + log1pf(__expf(-fabsf(x))); }
__device__ __forceinline__ float gelu_tanh(float x) {
  float u = 0.7978845608028654f * (x + 0.044715f * x * x * x);
  float t = 1.f - 2.f * __builtin_amdgcn_rcpf(__expf(2.f * u) + 1.f);
  return 0.5f * x * (1.f + t);
}
#define DPP_ADD(v, ctrl) ((v) + __int_as_float(__builtin_amdgcn_update_dpp(0, __float_as_int(v), (ctrl), 0xF, 0xF, true)))
__device__ __forceinline__ float wave_sum(float v) {
  v = DPP_ADD(v, 0xB1);
  v = DPP_ADD(v, 0x4E);
  v = DPP_ADD(v, 0x141);
  v = DPP_ADD(v, 0x140);
  v += __shfl_xor(v, 16, 64);
  v += __shfl_xor(v, 32, 64);
  return v;
}
__device__ __forceinline__ int row_modidx(int row) { return row < NCTX ? 0 : 1 + ((row - NCTX) >> 11); }
__device__ __forceinline__ bfu* ws_bf(const Params& p, size_t off) { return (bfu*)(p.ws + off); }

struct CvtJob { const float* src; bfu* dst; int K, Nsrc, Ndst, mode, coloff, limit; };

__device__ __forceinline__ void cvt_load(const CvtJob& j, int tile, float (&v)[8]) {
  const int nkt = j.K >> 6;
  const int n0 = (tile / nkt) << 6, k0 = (tile % nkt) << 6;
  const int tid = tid_();
  const int ng = tid & 15, kk = tid >> 4;
  const int np = n0 + ng * 4;
  int sc;
  bool valid = true;
  if (j.mode == 1) {
    int blk = np >> 5, w = np & 31;
    sc = (w < 16) ? (blk * 16 + w) : (2816 + blk * 16 + (w - 16));
  } else {
    sc = np + j.coloff;
    valid = np < j.limit;
  }
#pragma unroll
  for (int i = 0; i < 2; i++) {
    float4 t = valid ? *(const float4*)(j.src + (size_t)(k0 + kk + 32 * i) * j.Nsrc + sc) : make_float4(0.f, 0.f, 0.f, 0.f);
    v[i * 4 + 0] = t.x; v[i * 4 + 1] = t.y; v[i * 4 + 2] = t.z; v[i * 4 + 3] = t.w;
  }
}
__device__ __forceinline__ void cvt_store(const CvtJob& j, int tile, const float (&v)[8], char* lds) {
  float* tl = (float*)lds;
  const int nkt = j.K >> 6;
  const int n0 = (tile / nkt) << 6, k0 = (tile % nkt) << 6;
  const int tid = tid_();
  {
    const int ng = tid & 15, kk = tid >> 4;
#pragma unroll
    for (int i = 0; i < 2; i++)
#pragma unroll
      for (int c = 0; c < 4; c++) tl[(kk + 32 * i) * 65 + ng * 4 + c] = v[i * 4 + c];
  }
  __syncthreads();
  {
    const int nn2 = tid >> 3, kc = tid & 7;
    float f[8];
#pragma unroll
    for (int e = 0; e < 8; e++) f[e] = tl[(kc * 8 + e) * 65 + nn2];
    *(uint4*)(j.dst + (size_t)(n0 + nn2) * j.K + k0 + kc * 8) = pack8(f);
  }
  __syncthreads();
}

__device__ __forceinline__ CvtJob get_job(const Params& p, int l, int j) {
  CvtJob r;
  if (j == 0) r = {p.in[I_F1W13] + (size_t)l * 1024 * 5632, ws_bf(p, WS_W13A), 1024, 5632, 5632, 1, 0, 5632};
  else if (j == 1) r = {p.in[I_F1W2] + (size_t)l * 2816 * 1024, ws_bf(p, WS_W2A), 2816, 1024, 1024, 0, 0, 1024};
  else if (j == 2) r = {p.in[I_WIN] + (size_t)l * 1024 * NINP, ws_bf(p, WS_WIN), 1024, NINP, LDP, 0, 0, NPROJ};
  else if (j == 3) r = {p.in[I_WIN] + (size_t)l * 1024 * NINP, ws_bf(p, WS_WG), 1024, NINP, 4096, 0, NPROJ, 4096};
  else if (j < 8) r = {p.in[I_WBR] + (size_t)(l * 4 + (j - 4)) * 512 * 1024, ws_bf(p, WS_WBR) + (size_t)(j - 4) * 1024 * 512, 512, 1024, 1024, 0, 0, 1024};
  else if (j == 8) r = {p.in[I_WOUT] + (size_t)l * 1024 * 1024, ws_bf(p, WS_WOUT), 1024, 1024, 1024, 0, 0, 1024};
  else if (j == 9) r = {p.in[I_F2W13] + (size_t)l * 1024 * 5632, ws_bf(p, WS_W13B), 1024, 5632, 5632, 1, 0, 5632};
  else r = {p.in[I_F2W2] + (size_t)l * 2816 * 1024, ws_bf(p, WS_W2B), 2816, 1024, 1024, 0, 0, 1024};
  return r;
}
__device__ __forceinline__ int job_tiles(int j) {
  return (j == 0 || j == 9) ? 88 * 16 : (j == 1 || j == 10) ? 16 * 44 : (j == 2) ? (LDP / 64) * 16 : (j == 3) ? 64 * 16
         : (j < 8) ? 16 * 8 : 16 * 16;
}

__device__ __forceinline__ bool find_job(const Params& p, int l, int jlo, int jhi, int t, CvtJob& jb, int& tile) {
  int tt = t;
  for (int j = jlo; j < jhi; j++) {
    int n = job_tiles(j);
    if (tt < n) { jb = get_job(p, l, j); tile = tt; return true; }
    tt -= n;
  }
  return false;
}
__device__ __forceinline__ void convert_jobs(const Params& p, int l, int jlo, int jhi, char* lds) {
  CvtJob jc, jn;
  int tc = 0, tn = 0;
  float vc[8], vn[8];
  int t = blockIdx.x;
  bool have = find_job(p, l, jlo, jhi, t, jc, tc);
  if (have) cvt_load(jc, tc, vc);
  while (have) {
    t += gridDim.x;
    const bool have_n = find_job(p, l, jlo, jhi, t, jn, tn);
    if (have_n) cvt_load(jn, tn, vn);
    cvt_store(jc, tc, vc, lds);
    jc = jn; tc = tn; have = have_n;
#pragma unroll
    for (int i = 0; i < 8; i++) vc[i] = vn[i];
  }
}

__device__ __forceinline__ void phase_mods(const Params& p, char* lds) {
  float* sc = (float*)lds;
  float* red = sc + 9 * 1024;
  const int tid = tid_();
  for (int u = blockIdx.x; u < 288; u += gridDim.x) {
    const int l = u / 144, cb = u % 144;
    __syncthreads();
    for (int i = tid; i < 9 * 1024; i += NTHREADS) {
      int ci = i >> 10, k = i & 1023;
      float v = (ci == 0) ? p.in[I_CCTX][k] : p.in[I_C][(ci - 1) * 1024 + k];
      sc[i] = siluf_(v);
    }
    __syncthreads();
    const int col = cb * 64 + (tid & 63), kg = tid >> 6;
    const float* w = p.in[I_WADA] + (size_t)l * 1024 * 9216 + col;
    float a[9];
#pragma unroll
    for (int i = 0; i < 9; i++) a[i] = 0.f;
    for (int k = kg * 128; k < kg * 128 + 128; k++) {
      float wv = w[(size_t)k * 9216];
#pragma unroll
      for (int i = 0; i < 9; i++) a[i] += sc[i * 1024 + k] * wv;
    }
#pragma unroll
    for (int i = 0; i < 9; i++) red[(kg * 9 + i) * 64 + (tid & 63)] = a[i];
    __syncthreads();
    for (int i = tid; i < 9 * 64; i += NTHREADS) {
      int ci = i >> 6, cc = i & 63;
      float s = 0.f;
#pragma unroll
      for (int g = 0; g < 8; g++) s += red[(g * 9 + ci) * 64 + cc];
      int c2 = cb * 64 + cc;
      s += p.in[I_BADA][l * 9216 + c2];
      ((float*)(p.ws + WS_MODS))[(size_t)(l * 9 + ci) * 9216 + c2] = s;
    }
  }
}

__device__ __forceinline__ void sincos_d(double x, float& s, float& c) {
  const double TWO_PI = 6.283185307179586476925287;
  double k = rint(x / TWO_PI);
  double r = x - k * TWO_PI;
  double r2 = r * r;
  double ts = 1.0, tc = 1.0;
  for (int n = 14; n >= 1; n--) {
    ts = 1.0 - r2 / (double)((2 * n) * (2 * n + 1)) * ts;
    tc = 1.0 - r2 / (double)((2 * n - 1) * (2 * n)) * tc;
  }
  s = (float)(r * ts);
  c = (float)tc;
}

__device__ __forceinline__ void phase_rope_table(const Params& p) {
  float* rc = (float*)(p.ws + WS_ROPE);
  float* rs = rc + 1024;
  for (int i = blockIdx.x * NTHREADS + tid_(); i < 1024; i += gridDim.x * NTHREADS) {
    int pos = i >> 4, f = i & 15;
    float inv = powf(10000.f, -(float)f / 16.f);
    float ang = (float)pos * inv;
    float s, c;
    sincos_d((double)ang, s, c);
    rc[i] = c; rs[i] = s;
  }
}

__device__ __forceinline__ void phase_norm(const Params& p, int l, int which, bool first) {
  const int lane = tid_() & 63, w = tid_() >> 6;
  const float* g = p.in[which == 0 ? I_NF1 : (which == 1 ? I_NMIX : I_NF2)] + l * 1024;
  const float* mods = (const float*)(p.ws + WS_MODS);
  bfu* xn = ws_bf(p, WS_XN);
  for (int row = blockIdx.x * 8 + w; row < NTOK; row += gridDim.x * 8) {
    const float* src;
    if (first) src = (row < NCTX) ? p.in[I_XP] + (size_t)row * 1024 : p.in[I_XS] + (size_t)(row - NCTX) * 1024;
    else src = p.out + (size_t)row * 1024;
    float4 v[4];
    float ss = 0.f;
#pragma unroll
    for (int i = 0; i < 4; i++) {
      v[i] = *(const float4*)(src + i * 256 + lane * 4);
      ss += v[i].x * v[i].x + v[i].y * v[i].y + v[i].z * v[i].z + v[i].w * v[i].w;
    }
    ss = wave_sum(ss);
    const float r = rsqrtf(ss * (1.f / 1024.f) + 1e-6f);
    const float* mb = mods + (size_t)(l * 9 + row_modidx(row)) * 9216;
    const float* sh = mb + (which * 3) * 1024;
    const float* scl = mb + (which * 3 + 1) * 1024;
#pragma unroll
    for (int i = 0; i < 4; i++) {
      int c = i * 256 + lane * 4;
      float4 gg = *(const float4*)(g + c), s4 = *(const float4*)(sh + c), c4 = *(const float4*)(scl + c);
      float o0 = v[i].x * r * gg.x * (1.f + c4.x) + s4.x;
      float o1 = v[i].y * r * gg.y * (1.f + c4.y) + s4.y;
      float o2 = v[i].z * r * gg.z * (1.f + c4.z) + s4.z;
      float o3 = v[i].w * r * gg.w * (1.f + c4.w) + s4.w;
      uint2 pk; pk.x = pack2(o0, o1); pk.y = pack2(o2, o3);
      *(uint2*)(xn + (size_t)row * 1024 + c) = pk;
    }
  }
}

__device__ __forceinline__ void phase_final_norm(const Params& p) {
  const int lane = tid_() & 63, w = tid_() >> 6;
  const float* g = p.in[I_FN];
  for (int row = blockIdx.x * 8 + w; row < NTOK; row += gridDim.x * 8) {
    float* src = p.out + (size_t)row * 1024;
    float4 v[4];
    float ss = 0.f;
#pragma unroll
    for (int i = 0; i < 4; i++) {
      v[i] = *(const float4*)(src + i * 256 + lane * 4);
      ss += v[i].x * v[i].x + v[i].y * v[i].y + v[i].z * v[i].z + v[i].w * v[i].w;
    }
    ss = wave_sum(ss);
    const float r = rsqrtf(ss * (1.f / 1024.f) + 1e-6f);
#pragma unroll
    for (int i = 0; i < 4; i++) {
      int c = i * 256 + lane * 4;
      float4 gg = *(const float4*)(g + c);
      float4 o;
      o.x = v[i].x * r * gg.x; o.y = v[i].y * r * gg.y; o.z = v[i].z * r * gg.z; o.w = v[i].w * r * gg.w;
      *(float4*)(src + c) = o;
    }
  }
}

typedef unsigned u32x4 __attribute__((ext_vector_type(4)));
template <int MI>
__device__ __forceinline__ void gemm_compute(const char* sb, int fa_off, int fb_off, int lq, int sw, f32x4 (&acc)[MI][4]) {
#pragma unroll
  for (int ks = 0; ks < 2; ks++) {
    const int ch = ((ks * 4 + lq) ^ sw) << 4;
    bf16x8 af[MI], bfr[4];
#pragma unroll
    for (int mi = 0; mi < MI; mi++) af[mi] = *(const bf16x8*)(sb + fa_off + mi * 16 * 128 + ch);
#pragma unroll
    for (int ni = 0; ni < 4; ni++) bfr[ni] = *(const bf16x8*)(sb + fb_off + ni * 16 * 128 + ch);
#pragma unroll
    for (int mi = 0; mi < MI; mi++)
#pragma unroll
      for (int ni = 0; ni < 4; ni++)
        acc[mi][ni] = __builtin_amdgcn_mfma_f32_16x16x32_bf16(bfr[ni], af[mi], acc[mi][ni], 0, 0, 0);
  }
}

template <int MI>
__device__ __forceinline__ void gemm_main(const bfu* __restrict__ A, int lda, const bfu* __restrict__ Bt, int ldb,
                                          int K, f32x4 (&acc)[MI][4], char* lds) {
  constexpr int BM = 64 * MI;
  constexpr int STAGE = (BM + 128) * 128;
  const int tid = tid_(), lane = tid & 63, w = tid >> 6, wm = w >> 1, wn = w & 1;
  const int lrow = tid >> 3, lch = tid & 7;
  const bfu* ap = A + (size_t)lrow * lda + lch * 8;
  const bfu* bp = Bt + (size_t)lrow * ldb + lch * 8;
  const int st_off = lrow * 128 + ((lch ^ ((lrow >> 1) & 7)) << 4);
  const int sw = (lane & 15) >> 1, lq = lane >> 4;
  const int fa_off = (wm * 16 * MI + (lane & 15)) * 128;
  const int fb_off = BM * 128 + (wn * 64 + (lane & 15)) * 128;
  u32x4 ra0[MI], rb0[2], ra1[MI], rb1[2];
  const int nk = K >> 6;
  __syncthreads();
  {
      const int ko_ = (0) << 6;
#pragma unroll
      for (int i = 0; i < MI; i++) ra0[i] = *(const u32x4*)(ap + (size_t)i * 64 * lda + ko_);
#pragma unroll
      for (int i = 0; i < 2; i++) rb0[i] = *(const u32x4*)(bp + (size_t)i * 64 * ldb + ko_);
    }
  {
      const int ko_ = (1) << 6;
#pragma unroll
      for (int i = 0; i < MI; i++) ra1[i] = *(const u32x4*)(ap + (size_t)i * 64 * lda + ko_);
#pragma unroll
      for (int i = 0; i < 2; i++) rb1[i] = *(const u32x4*)(bp + (size_t)i * 64 * ldb + ko_);
    }
  {
#pragma unroll
      for (int i = 0; i < MI; i++) *(u32x4*)(lds + st_off + i * 64 * 128) = ra0[i];
#pragma unroll
      for (int i = 0; i < 2; i++) *(u32x4*)(lds + BM * 128 + st_off + i * 64 * 128) = rb0[i];
    }
  __syncthreads();
#pragma unroll 1
  for (int kt = 0; kt < nk; kt += 2) {
    {
      const int ko_ = ((kt + 2 < nk) ? kt + 2 : kt) << 6;
#pragma unroll
      for (int i = 0; i < MI; i++) ra0[i] = *(const u32x4*)(ap + (size_t)i * 64 * lda + ko_);
#pragma unroll
      for (int i = 0; i < 2; i++) rb0[i] = *(const u32x4*)(bp + (size_t)i * 64 * ldb + ko_);
    }
    gemm_compute<MI>(lds, fa_off, fb_off, lq, sw, acc);
    {
#pragma unroll
      for (int i = 0; i < MI; i++) *(u32x4*)((lds + STAGE) + st_off + i * 64 * 128) = ra1[i];
#pragma unroll
      for (int i = 0; i < 2; i++) *(u32x4*)((lds + STAGE) + BM * 128 + st_off + i * 64 * 128) = rb1[i];
    }
    __syncthreads();
    {
      const int ko_ = ((kt + 3 < nk) ? kt + 3 : kt) << 6;
#pragma unroll
      for (int i = 0; i < MI; i++) ra1[i] = *(const u32x4*)(ap + (size_t)i * 64 * lda + ko_);
#pragma unroll
      for (int i = 0; i < 2; i++) rb1[i] = *(const u32x4*)(bp + (size_t)i * 64 * ldb + ko_);
    }
    gemm_compute<MI>(lds + STAGE, fa_off, fb_off, lq, sw, acc);
    if (kt + 2 < nk) {
#pragma unroll
      for (int i = 0; i < MI; i++) *(u32x4*)(lds + st_off + i * 64 * 128) = ra0[i];
#pragma unroll
      for (int i = 0; i < 2; i++) *(u32x4*)(lds + BM * 128 + st_off + i * 64 * 128) = rb0[i];
    }
    __syncthreads();
  }
}

template <int MI>
__device__ __forceinline__ void gemm_main_ring(const bfu* __restrict__ A, int lda, const bfu* __restrict__ Bt, int ldb,
                                          int K, f32x4 (&acc)[MI][4], char* lds) {
  constexpr int BM = 64 * MI;
  constexpr int STAGE = (BM + 128) * 128;
  const int tid = tid_(), lane = tid & 63, w = tid >> 6, wm = w >> 1, wn = w & 1;
  const int lrow = tid >> 3, lch = tid & 7;
  const bfu* ap = A + (size_t)lrow * lda + lch * 8;
  const bfu* bp = Bt + (size_t)lrow * ldb + lch * 8;
  const int st_off = lrow * 128 + ((lch ^ ((lrow >> 1) & 7)) << 4);
  const int sw = (lane & 15) >> 1, lq = lane >> 4;
  const int fa_off = (wm * 16 * MI + (lane & 15)) * 128;
  const int fb_off = BM * 128 + (wn * 64 + (lane & 15)) * 128;
  u32x4 ra0[MI], rb0[2], ra1[MI], rb1[2], ra2[MI], rb2[2], ra3[MI], rb3[2];
  const int nk = K >> 6;
#define GL(RA, RB, T)                                                                                         \
  {                                                                                                           \
    const int ko_ = (((T) < nk) ? (T) : 0) << 6;                                                              \
    _Pragma("unroll") for (int i = 0; i < MI; i++) RA[i] = *(const u32x4*)(ap + (size_t)i * 64 * lda + ko_);  \
    _Pragma("unroll") for (int i = 0; i < 2; i++) RB[i] = *(const u32x4*)(bp + (size_t)i * 64 * ldb + ko_);   \
  }
#define GS(RA, RB, SB)                                                                                        \
  {                                                                                                           \
    _Pragma("unroll") for (int i = 0; i < MI; i++) *(u32x4*)((SB) + st_off + i * 64 * 128) = RA[i];           \
    _Pragma("unroll") for (int i = 0; i < 2; i++) *(u32x4*)((SB) + BM * 128 + st_off + i * 64 * 128) = RB[i]; \
  }
  __syncthreads();
  GL(ra0, rb0, 0);
  GL(ra1, rb1, 1);
  GL(ra2, rb2, 2);
  GS(ra0, rb0, lds);
  __syncthreads();
#pragma unroll 1
  for (int kt = 0; kt < nk; kt += 4) {
    GL(ra3, rb3, kt + 3);
    gemm_compute<MI>(lds, fa_off, fb_off, lq, sw, acc);
    GS(ra1, rb1, lds + STAGE);
    __syncthreads();
    GL(ra0, rb0, kt + 4);
    gemm_compute<MI>(lds + STAGE, fa_off, fb_off, lq, sw, acc);
    GS(ra2, rb2, lds);
    __syncthreads();
    GL(ra1, rb1, kt + 5);
    gemm_compute<MI>(lds, fa_off, fb_off, lq, sw, acc);
    GS(ra3, rb3, lds + STAGE);
    __syncthreads();
    GL(ra2, rb2, kt + 6);
    gemm_compute<MI>(lds + STAGE, fa_off, fb_off, lq, sw, acc);
    if (kt + 4 < nk) GS(ra0, rb0, lds);
    __syncthreads();
  }
#undef GL
#undef GS
}

__device__ __forceinline__ void gemm2_compute(const char* sb, int fa_off, int fb_off, int lq, int sw, f32x4 (&acc)[4][8]) {
#pragma unroll
  for (int ks = 0; ks < 2; ks++) {
    const int ch = ((ks * 4 + lq) ^ sw) << 4;
    bf16x8 af[4], bfr[8];
#pragma unroll
    for (int mi = 0; mi < 4; mi++) af[mi] = *(const bf16x8*)(sb + fa_off + mi * 16 * 128 + ch);
#pragma unroll
    for (int ni = 0; ni < 8; ni++) bfr[ni] = *(const bf16x8*)(sb + fb_off + ni * 16 * 128 + ch);
#pragma unroll
    for (int mi = 0; mi < 4; mi++)
#pragma unroll
      for (int ni = 0; ni < 8; ni++)
        acc[mi][ni] = __builtin_amdgcn_mfma_f32_16x16x32_bf16(bfr[ni], af[mi], acc[mi][ni], 0, 0, 0);
  }
}
__device__ __forceinline__ void gemm_main2(const bfu* __restrict__ A, int lda, const bfu* __restrict__ Bt, int ldb, int K,
                                           f32x4 (&acc)[4][8], char* lds) {
  constexpr int STAGE = 512 * 128;
  const int tid = tid_(), lane = tid & 63, w = tid >> 6, wm = w >> 1, wn = w & 1;
  const int lrow = tid >> 3, lch = tid & 7;
  const bfu* ap = A + (size_t)lrow * lda + lch * 8;
  const bfu* bp = Bt + (size_t)lrow * ldb + lch * 8;
  const int st_off = lrow * 128 + ((lch ^ ((lrow >> 1) & 7)) << 4);
  const int sw = (lane & 15) >> 1, lq = lane >> 4;
  const int fa_off = (wm * 64 + (lane & 15)) * 128;
  const int fb_off = 256 * 128 + (wn * 128 + (lane & 15)) * 128;
  u32x4 ra0[4], rb0[4], ra1[4], rb1[4];
  const int nk = K >> 6;
  __syncthreads();
#pragma unroll
  for (int i = 0; i < 4; i++) ra0[i] = *(const u32x4*)(ap + (size_t)i * 64 * lda);
#pragma unroll
  for (int i = 0; i < 4; i++) rb0[i] = *(const u32x4*)(bp + (size_t)i * 64 * ldb);
#pragma unroll
  for (int i = 0; i < 4; i++) ra1[i] = *(const u32x4*)(ap + (size_t)i * 64 * lda + 64);
#pragma unroll
  for (int i = 0; i < 4; i++) rb1[i] = *(const u32x4*)(bp + (size_t)i * 64 * ldb + 64);
#pragma unroll
  for (int i = 0; i < 4; i++) *(u32x4*)(lds + st_off + i * 64 * 128) = ra0[i];
#pragma unroll
  for (int i = 0; i < 4; i++) *(u32x4*)(lds + 256 * 128 + st_off + i * 64 * 128) = rb0[i];
  __syncthreads();
#pragma unroll 1
  for (int kt = 0; kt < nk; kt += 2) {
    {
      const int ko = ((kt + 2 < nk) ? kt + 2 : kt) << 6;
#pragma unroll
      for (int i = 0; i < 4; i++) ra0[i] = *(const u32x4*)(ap + (size_t)i * 64 * lda + ko);
#pragma unroll
      for (int i = 0; i < 4; i++) rb0[i] = *(const u32x4*)(bp + (size_t)i * 64 * ldb + ko);
    }
    gemm2_compute(lds, fa_off, fb_off, lq, sw, acc);
#pragma unroll
    for (int i = 0; i < 4; i++) *(u32x4*)(lds + STAGE + st_off + i * 64 * 128) = ra1[i];
#pragma unroll
    for (int i = 0; i < 4; i++) *(u32x4*)(lds + STAGE + 256 * 128 + st_off + i * 64 * 128) = rb1[i];
    __syncthreads();
    {
      const int ko = ((kt + 3 < nk) ? kt + 3 : kt) << 6;
#pragma unroll
      for (int i = 0; i < 4; i++) ra1[i] = *(const u32x4*)(ap + (size_t)i * 64 * lda + ko);
#pragma unroll
      for (int i = 0; i < 4; i++) rb1[i] = *(const u32x4*)(bp + (size_t)i * 64 * ldb + ko);
    }
    gemm2_compute(lds + STAGE, fa_off, fb_off, lq, sw, acc);
    if (kt + 2 < nk) {
#pragma unroll
      for (int i = 0; i < 4; i++) *(u32x4*)(lds + st_off + i * 64 * 128) = ra0[i];
#pragma unroll
      for (int i = 0; i < 4; i++) *(u32x4*)(lds + 256 * 128 + st_off + i * 64 * 128) = rb0[i];
    }
    __syncthreads();
  }
}

template <int MI>
__device__ __forceinline__ void zero_acc(f32x4 (&acc)[MI][4]) {
#pragma unroll
  for (int mi = 0; mi < MI; mi++)
#pragma unroll
    for (int ni = 0; ni < 4; ni++) acc[mi][ni] = f32x4{0.f, 0.f, 0.f, 0.f};
}

__device__ __forceinline__ void remap_tile(int t, int nM, int nN, int& tm, int& tn) {
  const int band = nM >> 3;
  if ((nM & 7) == 0 && band % 5 == 0) {
    const int x = t & 7, q = t >> 3;
    const int per = 5 * nN;
    const int sb = q / per, r = q % per;
    tm = x * band + sb * 5 + r % 5;
    tn = r / 5;
  } else {
    tm = t % nM;
    tn = t / nM;
  }
}

__device__ __forceinline__ void phase_gemm_w13(const Params& p, size_t wsoff, char* lds) {
  const bfu* A = ws_bf(p, WS_XN);
  const bfu* W = ws_bf(p, wsoff);
  bfu* act = ws_bf(p, WS_PROJ);
  const int lane = tid_() & 63, w = tid_() >> 6, wm = w >> 1, wn = w & 1;
  const int nM = NTOK / 256, nN = 5632 / 256;
  for (int t = blockIdx.x; t < nM * nN; t += gridDim.x) {
    int tm, tn;
    remap_tile(t, nM, nN, tm, tn);
    f32x4 acc[4][8];
#pragma unroll
    for (int mi = 0; mi < 4; mi++)
#pragma unroll
      for (int ni = 0; ni < 8; ni++) acc[mi][ni] = f32x4{0.f, 0.f, 0.f, 0.f};
    gemm_main2(A + (size_t)tm * 256 * 1024, 1024, W + (size_t)tn * 256 * 1024, 1024, 1024, acc, lds);
#pragma unroll
    for (int mi = 0; mi < 4; mi++)
#pragma unroll
      for (int np = 0; np < 4; np++) {
        const int row = tm * 256 + wm * 64 + mi * 16 + (lane & 15);
        const int col = tn * 128 + wn * 64 + np * 16 + (lane >> 4) * 4;
        float o[4];
#pragma unroll
        for (int j = 0; j < 4; j++) o[j] = siluf_(acc[mi][np * 2][j]) * acc[mi][np * 2 + 1][j];
        uint2 pk; pk.x = pack2(o[0], o[1]); pk.y = pack2(o[2], o[3]);
        *(uint2*)(act + (size_t)row * DFF + col) = pk;
      }
  }
}

template <int MI>
__device__ __forceinline__ void gemm_res_tile(const Params& p, int l, const bfu* A, int lda, int K, const bfu* W, int midx,
                                              float coef, bool first, int row0, int tn, char* lds, bool dry) {
  const float* mods = (const float*)(p.ws + WS_MODS);
  const int lane = tid_() & 63, w = tid_() >> 6, wm = w >> 1, wn = w & 1;
  f32x4 acc[MI][4];
  zero_acc<MI>(acc);
  gemm_main<MI>(A + (size_t)row0 * lda, lda, W + (size_t)tn * 128 * K, K, K, acc, lds);
#pragma unroll
  for (int mi = 0; mi < MI; mi++) {
    const int row = row0 + wm * 16 * MI + mi * 16 + (lane & 15);
    const float* mrow = mods + (size_t)(l * 9 + row_modidx(row)) * 9216 + midx * 1024;
    const float* res;
    if (first) res = (row < NCTX) ? p.in[I_XP] + (size_t)row * 1024 : p.in[I_XS] + (size_t)(row - NCTX) * 1024;
    else res = p.out + (size_t)row * 1024;
    float* dst = p.out + (size_t)row * 1024;
#pragma unroll
    for (int ni = 0; ni < 4; ni++) {
      const int col = tn * 128 + wn * 64 + ni * 16 + (lane >> 4) * 4;
      const float4 r4 = *(const float4*)(res + col), m4 = *(const float4*)(mrow + col);
      float4 o;
      o.x = r4.x + coef * m4.x * acc[mi][ni][0];
      o.y = r4.y + coef * m4.y * acc[mi][ni][1];
      o.z = r4.z + coef * m4.z * acc[mi][ni][2];
      o.w = r4.w + coef * m4.w * acc[mi][ni][3];
      if (!dry || o.x == 123456.789f) *(float4*)(dst + col) = o;
    }
  }
}

__device__ __forceinline__ void phase_gemm_res(const Params& p, int l, const bfu* A, int lda, int K, size_t wsoff, int midx,
                                               float coef, bool first, char* lds, bool dry = false) {
  const bfu* W = ws_bf(p, wsoff);
  const int nM = NTOK / 256, ntiles = nM * 8;
  const int nfull = (ntiles / (int)gridDim.x) * (int)gridDim.x;
  for (int t = blockIdx.x; t < nfull; t += gridDim.x)
  {
    int tm, tn;
    remap_tile(t, nM, 8, tm, tn);
    gemm_res_tile<4>(p, l, A, lda, K, W, midx, coef, first, tm * 256, tn, lds, dry);
  }
  for (int s = blockIdx.x; s < (ntiles - nfull) * 2; s += gridDim.x) {
    const int big = nfull + (s >> 1);
    int tm, tn;
    remap_tile(big, nM, 8, tm, tn);
    gemm_res_tile<2>(p, l, A, lda, K, W, midx, coef, first, tm * 256 + (s & 1) * 128, tn, lds, dry);
  }
}

__device__ __forceinline__ void phase_gemm_win(const Params& p, char* lds) {
  const bfu* A = ws_bf(p, WS_XN);
  const bfu* W = ws_bf(p, WS_WIN);
  bfu* proj = ws_bf(p, WS_PROJ);
  float* ctrl = (float*)(p.ws + WS_CTRL);
  const int lane = tid_() & 63, w = tid_() >> 6, wm = w >> 1, wn = w & 1;
  const int nM = NTOK / 256, nN = LDP / 256;
  for (int t = blockIdx.x; t < nM * nN; t += gridDim.x) {
    int tm, tn;
    remap_tile(t, nM, nN, tm, tn);
    f32x4 acc[4][8];
#pragma unroll
    for (int mi = 0; mi < 4; mi++)
#pragma unroll
      for (int ni = 0; ni < 8; ni++) acc[mi][ni] = f32x4{0.f, 0.f, 0.f, 0.f};
    gemm_main2(A + (size_t)tm * 256 * 1024, 1024, W + (size_t)tn * 256 * 1024, 1024, 1024, acc, lds);
#pragma unroll
    for (int ni = 0; ni < 8; ni++) {
      const int cb = tn * 256 + wn * 128 + ni * 16;
      const int col = cb + (lane >> 4) * 4;
      int cc = -1;
      if (cb == C_DT) cc = (lane >> 4) * 4;
      else if (cb == C_BETA) cc = 16 + (lane >> 4) * 4;
      else if (cb == C_AC) cc = 32 + (lane >> 4) * 4;
#pragma unroll
      for (int mi = 0; mi < 4; mi++) {
        const int row = tm * 256 + wm * 64 + mi * 16 + (lane & 15);
        uint2 pk; pk.x = pack2(acc[mi][ni][0], acc[mi][ni][1]); pk.y = pack2(acc[mi][ni][2], acc[mi][ni][3]);
        *(uint2*)(proj + (size_t)row * LDP + col) = pk;
        if (cc >= 0) *(float4*)(ctrl + (size_t)row * 48 + cc) = make_float4(acc[mi][ni][0], acc[mi][ni][1], acc[mi][ni][2], acc[mi][ni][3]);
      }
    }
  }
}

__device__ __forceinline__ void phase_gemm_merge(const Params& p, char* lds) {
  const bfu* XN = ws_bf(p, WS_XN);
  const bfu* WG = ws_bf(p, WS_WG);
  const bfu* WB = ws_bf(p, WS_WBR);
  bfu* proj = ws_bf(p, WS_PROJ);
  const int lane = tid_() & 63, w = tid_() >> 6, wm = w >> 1, wn = w & 1;
  const int nM = NTOK / 128, nN = 8;
  for (int t = blockIdx.x; t < nM * nN; t += gridDim.x) {
    int tm, tn;
    remap_tile(t, nM, nN, tm, tn);
    f32x4 mrg[2][4];
    zero_acc<2>(mrg);
#pragma unroll 1
    for (int n = 0; n < 4; n++) {
      f32x4 g[2][4], a[2][4];
      zero_acc<2>(g);
      gemm_main_ring<2>(XN + (size_t)tm * 128 * 1024, 1024, WG + (size_t)(n * 1024 + tn * 128) * 1024, 1024, 1024, g, lds);
      zero_acc<2>(a);
      gemm_main_ring<2>(proj + (size_t)tm * 128 * LDP + (n == 0 ? C_Z : n == 1 ? C_QB : n == 2 ? C_GC : C_YD), LDP, WB + (size_t)(n * 1024 + tn * 128) * 512, 512, 512, a, lds);
#pragma unroll
      for (int mi = 0; mi < 2; mi++)
#pragma unroll
        for (int ni = 0; ni < 4; ni++)
#pragma unroll
          for (int j = 0; j < 4; j++) mrg[mi][ni][j] += sigmoidf_(g[mi][ni][j]) * a[mi][ni][j];
    }
#pragma unroll
    for (int mi = 0; mi < 2; mi++)
#pragma unroll
      for (int ni = 0; ni < 4; ni++) {
        const int row = tm * 128 + wm * 32 + mi * 16 + (lane & 15);
        const int col = tn * 128 + wn * 64 + ni * 16 + (lane >> 4) * 4;
        uint2 pk; pk.x = pack2(mrg[mi][ni][0], mrg[mi][ni][1]); pk.y = pack2(mrg[mi][ni][2], mrg[mi][ni][3]);
        *(uint2*)(proj + (size_t)row * LDP + C_MRG + col) = pk;
      }
  }
}

__device__ __forceinline__ void phase_prep(const Params& p, int l) {
  const int lane = tid_() & 63, w = tid_() >> 6;
  bfu* proj = ws_bf(p, WS_PROJ);
  const float gq = p.in[I_QN][l * 64 + lane], gk = p.in[I_KN][l * 64 + lane];
  const float* rc = (const float*)(p.ws + WS_ROPE);
  const float* rs = rc + 1024;
  for (int row = blockIdx.x * 8 + w; row < NTOK; row += gridDim.x * 8) {
    const bool lat = row >= NCTX;
    const int t = lat ? ((row - NCTX) & 2047) : (row & 255);
    float cs = 1.f, sn = 0.f;
    if (lat) {
      int pos = (lane < 32) ? (t >> 6) : (t & 63);
      cs = rc[pos * 16 + (lane & 15)];
      sn = rs[pos * 16 + (lane & 15)];
    }
    const bool hi = (lane >> 4) & 1;
    for (int hv = 0; hv < 10; hv++) {
      bfu* ptr = proj + (size_t)row * LDP + (hv < 8 ? C_QB + hv * 64 : C_KB + (hv - 8) * 64) + lane;
      float x = bf2f(*ptr);
      float ss = wave_sum(x * x);
      float y = x * rsqrtf(ss * (1.f / 64.f) + 1e-6f) * (hv < 8 ? gq : gk);
      float o = y;
      if (lat) {
        float pr = __shfl_xor(y, 16, 64);
        o = hi ? (pr * sn + y * cs) : (y * cs - pr * sn);
      }
      *ptr = f2bf(o);
      if (!lat && hv >= 8) {
        int b = row >> 8;
        size_t idx = ((((size_t)b * 2 + l) * 256 + t) * 2 + (hv - 8)) * 64 + lane;
        p.out[O_NK + idx] = y;
        p.out[O_NV + idx] = bf2f(proj[(size_t)row * LDP + C_VB + (hv - 8) * 64 + lane]);
      }
    }
  }
}

__device__ __forceinline__ void conv8(const bfu* proj, int row0, int T, int tt, int col, const float* cw, int cwld,
                                      int cidx, const float* cb, float* o) {
  float4 b0 = *(const float4*)(cb + cidx), b1 = *(const float4*)(cb + cidx + 4);
  o[0] = b0.x; o[1] = b0.y; o[2] = b0.z; o[3] = b0.w; o[4] = b1.x; o[5] = b1.y; o[6] = b1.z; o[7] = b1.w;
#pragma unroll
  for (int j = 0; j < 4; j++) {
    int t2 = tt + j - 2;
    if (t2 >= 0 && t2 < T) {
      uint4 xv = *(const uint4*)(proj + (size_t)(row0 + t2) * LDP + col);
      float x[8];
      unpack8(xv, x);
      float4 w0 = *(const float4*)(cw + j * cwld + cidx), w1 = *(const float4*)(cw + j * cwld + cidx + 4);
      o[0] += w0.x * x[0]; o[1] += w0.y * x[1]; o[2] += w0.z * x[2]; o[3] += w0.w * x[3];
      o[4] += w1.x * x[4]; o[5] += w1.y * x[5]; o[6] += w1.z * x[6]; o[7] += w1.w * x[7];
    }
  }
}

__device__ __forceinline__ void scan_out(const float* ol, bfu* bufy, int row0, int ts, int dir, int t8, int colbase,
                                         bool second) {
  const int s = t8 >> 3, dc = t8 & 7;
  const int tt = dir ? ts + 31 - s : ts + s;
  float f[8];
  float4 a = *(const float4*)(ol + s * 64 + dc * 8), b = *(const float4*)(ol + s * 64 + dc * 8 + 4);
  f[0] = a.x; f[1] = a.y; f[2] = a.z; f[3] = a.w; f[4] = b.x; f[5] = b.y; f[6] = b.z; f[7] = b.w;
  bfu* dst = bufy + (size_t)(row0 + tt) * 512 + colbase + dc * 8;
  if (second) {
    float e[8];
    unpack8(*(const uint4*)dst, e);
#pragma unroll
    for (int i = 0; i < 8; i++) f[i] += e[i];
  }
  *(uint4*)dst = pack8(f);
}

typedef float f32x2 __attribute__((ext_vector_type(2)));
__device__ __forceinline__ float quad_sum(float v) {
  v += __int_as_float(__builtin_amdgcn_update_dpp(0, __float_as_int(v), 0xB1, 0xF, 0xF, true));
  v += __int_as_float(__builtin_amdgcn_update_dpp(0, __float_as_int(v), 0x4E, 0xF, 0xF, true));
  return v;
}
__device__ __forceinline__ float oct_sum(float v) {
  v = quad_sum(v);
  v = DPP_ADD(v, 0x141);
  return v;
}
__device__ __forceinline__ void load_taps(const bfu* proj, int row0, int T, int tt, int col, uint4 (&raw)[4]) {
#pragma unroll
  for (int j = 0; j < 4; j++) {
    int t2 = tt + j - 2;
    raw[j] = (t2 >= 0 && t2 < T) ? *(const uint4*)(proj + (size_t)(row0 + t2) * LDP + col) : make_uint4(0, 0, 0, 0);
  }
}
__device__ __forceinline__ void conv_lds(const uint4 (&raw)[4], const float* cwl, int dc, float* o) {
  {
    float4 b0 = *(const float4*)(cwl + 4 * 64 + dc * 8), b1 = *(const float4*)(cwl + 4 * 64 + dc * 8 + 4);
    o[0] = b0.x; o[1] = b0.y; o[2] = b0.z; o[3] = b0.w; o[4] = b1.x; o[5] = b1.y; o[6] = b1.z; o[7] = b1.w;
  }
#pragma unroll
  for (int j = 0; j < 4; j++) {
    float x[8];
    unpack8(raw[j], x);
    float4 w0 = *(const float4*)(cwl + j * 64 + dc * 8), w1 = *(const float4*)(cwl + j * 64 + dc * 8 + 4);
    o[0] += w0.x * x[0]; o[1] += w0.y * x[1]; o[2] += w0.z * x[2]; o[3] += w0.w * x[3];
    o[4] += w1.x * x[4]; o[5] += w1.y * x[5]; o[6] += w1.z * x[6]; o[7] += w1.w * x[7];
  }
}
__device__ __forceinline__ void ld16(const float* src, f32x2 (&d)[8]) {
#pragma unroll
  for (int i = 0; i < 4; i++) {
    float4 a = *(const float4*)(src + i * 4);
    d[2 * i] = f32x2{a.x, a.y};
    d[2 * i + 1] = f32x2{a.z, a.w};
  }
}

typedef __attribute__((ext_vector_type(16))) float f32x16;
#define MFMA32(a, b, c) __builtin_amdgcn_mfma_f32_32x32x16_bf16((a), (b), (c), 0, 0, 0)
__device__ __forceinline__ int crow32(int r, int hi) { return (r & 3) + 8 * (r >> 2) + 4 * hi; }
__device__ __forceinline__ void st16bf(bfu* dst, const f32x2 (&S)[8]) {
  float f[16];
#pragma unroll
  for (int i = 0; i < 8; i++) { f[2 * i] = S[i].x; f[2 * i + 1] = S[i].y; }
  *(uint4*)dst = pack8(f);
  *(uint4*)(dst + 8) = pack8(f + 8);
}
__device__ __forceinline__ float prefix32(float x, int lane) {
#pragma unroll
  for (int off = 1; off < 32; off <<= 1) {
    float t = __shfl_up(x, off, 64);
    if (lane >= off) x += t;
  }
  return x;
}

__device__ __forceinline__ void delta_unit(const Params& p, int l, int seq, int h, char* lds) {
  const int tid = tid_(), dir = tid >> 8, t8 = tid & 255;
  const bool lat = seq >= 16;
  const int b = lat ? seq - 16 : seq, T = lat ? 2048 : 256, row0 = lat ? NCTX + b * 2048 : b * 256;
  char* dbase = lds + dir * 59776;
  float* vl = (float*)dbase;
  float* Ml = (float*)(dbase + 8192);
  bfu* kdT = (bfu*)(dbase + 12800);
  float* ol = (float*)(dbase + 17920);
  bfu* qb = (bfu*)(dbase + 26112), *kb = (bfu*)(dbase + 30720), *s0t = (bfu*)(dbase + 35328), *vnt = (bfu*)(dbase + 44544),
      *qkb = (bfu*)(dbase + 49664);
  float* bl = (float*)(dbase + 52224), *egc = bl + 32, *gcm = bl + 64, *wl = bl + 96;
  float* cwl = (float*)(dbase + 52736);
  const bfu* proj = ws_bf(p, WS_PROJ);
  const float* ctrl = (const float*)(p.ws + WS_CTRL);
  bfu* bufy = ws_bf(p, WS_BUFY) + (size_t)1 * NTOK * 512;
  const int s_ld = t8 >> 3, dc = t8 & 7;
  const int wv = t8 >> 6, lane = t8 & 63, m32 = lane & 31, hi = lane >> 5;
  const int kt = wv >> 1, vt = wv & 1;
  __syncthreads();
  {
    const float* cw = p.in[I_DCW] + (size_t)l * 4 * 1536;
    const float* cb = p.in[I_DCB] + (size_t)l * 1536;
    for (int i = t8; i < 960; i += 256) {
      int m = i / 320, j = (i % 320) >> 6, d = i & 63;
      cwl[i] = (j < 4) ? cw[j * 1536 + m * 512 + h * 64 + d] : cb[m * 512 + h * 64 + d];
    }
  }
  f32x16 Sacc;
  if (lat) {
    const float* s0 = p.in[I_SDELTA] + ((((size_t)b * 2 + l) * 2 + dir) * 8 + h) * 4096;
#pragma unroll
    for (int r = 0; r < 16; r++) Sacc[r] = s0[(kt * 32 + crow32(r, hi)) * 64 + vt * 32 + m32];
  } else {
#pragma unroll
    for (int r = 0; r < 16; r++) Sacc[r] = 0.f;
  }
  const float neg_a = -__expf(p.in[I_DALOG][(l * 2 + dir) * 8 + h]);
  const float dtb = p.in[I_DDTB][(l * 2 + dir) * 8 + h];
  const int nc = T >> 5;
  uint4 raw[3][4];
  float c_a = 0.f, c_b = 0.f;
  {
    const int ts = (dir ? nc - 1 : 0) << 5;
    const int tt = dir ? ts + 31 - s_ld : ts + s_ld;
#pragma unroll
    for (int m = 0; m < 3; m++) load_taps(proj, row0, T, tt, C_QC + m * 512 + h * 64 + dc * 8, raw[m]);
    if (t8 < 32) {
      const int tt2 = dir ? ts + 31 - t8 : ts + t8;
      const float* cr = ctrl + (size_t)(row0 + tt2) * 48;
      c_a = cr[32 + dir * 8 + h]; c_b = cr[16 + dir * 8 + h];
    }
  }
  __syncthreads();
  for (int c = 0; c < nc; c++) {
    const int ts = (dir ? nc - 1 - c : c) << 5;
#pragma unroll
    for (int g4 = 0; g4 < 4; g4++) {
      uint2 pk;
      pk.x = pack2(Sacc[4 * g4], Sacc[4 * g4 + 1]);
      pk.y = pack2(Sacc[4 * g4 + 2], Sacc[4 * g4 + 3]);
      *(uint2*)(s0t + (vt * 32 + m32) * 72 + kt * 32 + 8 * g4 + 4 * hi) = pk;
    }
    if (t8 < 32) {
      const float g = neg_a * softplusf_(c_a + dtb);
      const float gc = prefix32(g, t8);
      const float gc_end = __shfl(gc, 31, 64);
      bl[t8] = sigmoidf_(c_b);
      gcm[t8] = gc;
      egc[t8] = __expf(gc);
      wl[t8] = __expf(gc_end - gc);
    }
    __syncthreads();
    {
      const float wsc = wl[s_ld];
      float oq[8], ok[8], ov[8];
      conv_lds(raw[0], cwl, dc, oq);
      conv_lds(raw[1], cwl + 320, dc, ok);
      conv_lds(raw[2], cwl + 640, dc, ov);
      float sq = 0.f, sk = 0.f;
#pragma unroll
      for (int i = 0; i < 8; i++) {
        oq[i] = siluf_(oq[i]); ok[i] = siluf_(ok[i]); ov[i] = siluf_(ov[i]);
        sq += oq[i] * oq[i]; sk += ok[i] * ok[i];
      }
      sq = oct_sum(sq); sk = oct_sum(sk);
      const float rq = rsqrtf(sq + 1e-6f) * 0.125f, rk = rsqrtf(sk + 1e-6f);
#pragma unroll
      for (int i = 0; i < 8; i++) { oq[i] *= rq; ok[i] *= rk; }
      *(uint4*)(qb + s_ld * 72 + dc * 8) = pack8(oq);
      *(uint4*)(kb + s_ld * 72 + dc * 8) = pack8(ok);
#pragma unroll
      for (int i = 0; i < 8; i += 2) {
        const unsigned pw = pack2(ok[i] * wsc, ok[i + 1] * wsc);
        kdT[(dc * 8 + i) * 40 + s_ld] = (bfu)(pw & 0xffff);
        kdT[(dc * 8 + i + 1) * 40 + s_ld] = (bfu)(pw >> 16);
      }
      *(float4*)(vl + s_ld * 64 + dc * 8) = make_float4(ov[0], ov[1], ov[2], ov[3]);
      *(float4*)(vl + s_ld * 64 + dc * 8 + 4) = make_float4(ov[4], ov[5], ov[6], ov[7]);
    }
    __syncthreads();
    {
      f32x16 acc;
#pragma unroll
      for (int r = 0; r < 16; r++) acc[r] = 0.f;
      const bfu* bsrc = (wv < 2) ? (s0t + (wv * 32 + m32) * 72) : (kb + m32 * 72);
      const bfu* asrc = (wv == 3) ? (qb + m32 * 72) : (kb + m32 * 72);
#pragma unroll
      for (int kk = 0; kk < 4; kk++) {
        const bf16x8 a = *(const bf16x8*)(asrc + kk * 16 + hi * 8);
        const bf16x8 bb = *(const bf16x8*)(bsrc + kk * 16 + hi * 8);
        acc = MFMA32(a, bb, acc);
      }
      if (wv < 2) {
#pragma unroll
        for (int r = 0; r < 16; r++) {
          const int s = crow32(r, hi);
          float* pv = vl + s * 64 + wv * 32 + m32;
          *pv = bl[s] * (*pv - egc[s] * acc[r]);
        }
      } else {
        const float gj = gcm[m32];
#pragma unroll
        for (int r = 0; r < 16; r++) {
          const int i = crow32(r, hi);
          const float dec = __expf(gcm[i] - gj);
          if (wv == 2) Ml[i * 36 + m32] = (m32 < i) ? bl[i] * acc[r] * dec : 0.f;
          else qkb[i * 40 + m32] = f2bf((m32 <= i) ? acc[r] * dec : 0.f);
        }
      }
    }
    __syncthreads();
    if (wv == dir) {
      float x[16];
#pragma unroll
      for (int i = 0; i < 16; i++) {
        float a = vl[i * 64 + lane];
#pragma unroll
        for (int j = 0; j < i; j++) a -= Ml[i * 36 + j] * x[j];
        x[i] = a;
      }
#pragma unroll
      for (int i = 0; i < 16; i += 2) *(unsigned*)(vnt + lane * 40 + i) = pack2(x[i], x[i + 1]);
#pragma unroll 1
      for (int i = 16; i < 32; i++) {
        float a = vl[i * 64 + lane];
        const float* mr = Ml + i * 36;
#pragma unroll
        for (int j = 0; j < 16; j++) a -= mr[j] * x[j];
        vl[i * 64 + lane] = a;
      }
#pragma unroll
      for (int i = 0; i < 16; i++) {
        float a = vl[(16 + i) * 64 + lane];
#pragma unroll
        for (int j = 0; j < i; j++) a -= Ml[(16 + i) * 36 + 16 + j] * x[j];
        x[i] = a;
      }
#pragma unroll
      for (int i = 0; i < 16; i += 2) *(unsigned*)(vnt + lane * 40 + 16 + i) = pack2(x[i], x[i + 1]);
    }
    __syncthreads();
    if (c + 1 < nc) {
      const int ts2 = (dir ? nc - 2 - c : c + 1) << 5;
      const int tt = dir ? ts2 + 31 - s_ld : ts2 + s_ld;
#pragma unroll
      for (int m = 0; m < 3; m++) load_taps(proj, row0, T, tt, C_QC + m * 512 + h * 64 + dc * 8, raw[m]);
      if (t8 < 32) {
        const int tt2 = dir ? ts2 + 31 - t8 : ts2 + t8;
        const float* cr = ctrl + (size_t)(row0 + tt2) * 48;
        c_a = cr[32 + dir * 8 + h]; c_b = cr[16 + dir * 8 + h];
      }
    }
    {
      const float dtot = egc[31];
#pragma unroll
      for (int r = 0; r < 16; r++) Sacc[r] *= dtot;
#pragma unroll
      for (int jj = 0; jj < 2; jj++) {
        const bf16x8 a = *(const bf16x8*)(kdT + (kt * 32 + m32) * 40 + jj * 16 + hi * 8);
        const bf16x8 bb = *(const bf16x8*)(vnt + (vt * 32 + m32) * 40 + jj * 16 + hi * 8);
        Sacc = MFMA32(a, bb, Sacc);
      }
    }
    if (wv < 2) {
      const int v0 = wv * 32;
      f32x16 acc;
#pragma unroll
      for (int r = 0; r < 16; r++) acc[r] = 0.f;
#pragma unroll
      for (int kk = 0; kk < 4; kk++) {
        const bf16x8 a = *(const bf16x8*)(qb + m32 * 72 + kk * 16 + hi * 8);
        const bf16x8 bb = *(const bf16x8*)(s0t + (v0 + m32) * 72 + kk * 16 + hi * 8);
        acc = MFMA32(a, bb, acc);
      }
#pragma unroll
      for (int r = 0; r < 16; r++) acc[r] *= egc[crow32(r, hi)];
#pragma unroll
      for (int jj = 0; jj < 2; jj++) {
        const bf16x8 a = *(const bf16x8*)(qkb + m32 * 40 + jj * 16 + hi * 8);
        const bf16x8 bb = *(const bf16x8*)(vnt + (v0 + m32) * 40 + jj * 16 + hi * 8);
        acc = MFMA32(a, bb, acc);
      }
#pragma unroll
      for (int r = 0; r < 16; r++) ol[crow32(r, hi) * 64 + v0 + m32] = acc[r];
    }
    __syncthreads();
    scan_out(ol, bufy, row0, ts, dir, t8, h * 64, c >= (nc >> 1));
    if (c == (nc >> 1) - 1) __threadfence();
  }
  if (!lat) {
    float* dst = p.out + O_DELTA + ((((size_t)b * 2 + l) * 2 + dir) * 8 + h) * 4096;
#pragma unroll
    for (int r = 0; r < 16; r++) dst[(kt * 32 + crow32(r, hi)) * 64 + vt * 32 + m32] = Sacc[r];
  }
}

__device__ __forceinline__ void ssd_unit(const Params& p, int l, int seq, int h, char* lds) {
  const int tid = tid_(), dir = tid >> 8, t8 = tid & 255;
  const bool lat = seq >= 16;
  const int b = lat ? seq - 16 : seq, T = lat ? 2048 : 256, row0 = lat ? NCTX + b * 2048 : b * 256;
  char* dbase = lds + dir * 59776;
  float* xl = (float*)dbase;
  bfu* xwT = (bfu*)(dbase + 8192), *bT = (bfu*)(dbase + 13312);
  float* ol = (float*)(dbase + 18432);
  bfu* cbf = (bfu*)(dbase + 26624), *bbf = (bfu*)(dbase + 31232), *h0b = (bfu*)(dbase + 35840), *xT = (bfu*)(dbase + 45056),
      *scb = (bfu*)(dbase + 50176);
  float* dtl = (float*)(dbase + 55296), *eal = dtl + 32, *acl = dtl + 64, *wl = dtl + 96;
  float* cwl = (float*)(dbase + 55936);
  const bfu* proj = ws_bf(p, WS_PROJ);
  const float* ctrl = (const float*)(p.ws + WS_CTRL);
  bfu* bufy = ws_bf(p, WS_BUFY);
  const int s_ld = t8 >> 3, dc = t8 & 7;
  const int wv = t8 >> 6, lane = t8 & 63, m32 = lane & 31, hi = lane >> 5;
  const int pt = wv >> 1, nt = wv & 1;
  const int grp = h >> 2;
  __syncthreads();
  {
    const float* cw = p.in[I_SCW] + (size_t)l * 4 * 768;
    const float* cb = p.in[I_SCB] + (size_t)l * 768;
    for (int i = t8; i < 960; i += 256) {
      int m = i / 320, j = (i % 320) >> 6, d = i & 63;
      int cidx = (m == 0) ? h * 64 + d : (m == 1 ? 512 + grp * 64 + d : 640 + grp * 64 + d);
      cwl[i] = (j < 4) ? cw[j * 768 + cidx] : cb[cidx];
    }
  }
  f32x16 Hacc;
  if (lat) {
    const float* s0 = p.in[I_SSSM] + ((((size_t)b * 2 + l) * 2 + dir) * 8 + h) * 4096;
#pragma unroll
    for (int r = 0; r < 16; r++) Hacc[r] = s0[(pt * 32 + crow32(r, hi)) * 64 + nt * 32 + m32];
  } else {
#pragma unroll
    for (int r = 0; r < 16; r++) Hacc[r] = 0.f;
  }
  const float a_ssm = -__expf(p.in[I_SALOG][(l * 2 + dir) * 8 + h]);
  const float dtb = p.in[I_SDTB][(l * 2 + dir) * 8 + h];
  const float Dh = (dir == 0) ? p.in[I_SD][l * 8 + h] : 0.f;
  const int nc = T >> 5;
  const int col0 = C_XBC + h * 64 + dc * 8, col1 = C_XBC + 512 + grp * 64 + dc * 8, col2 = C_XBC + 640 + grp * 64 + dc * 8;
  uint4 raw[3][4];
  float c_dt = 0.f;
  {
    const int ts = (dir ? nc - 1 : 0) << 5;
    const int tt = dir ? ts + 31 - s_ld : ts + s_ld;
    load_taps(proj, row0, T, tt, col0, raw[0]);
    load_taps(proj, row0, T, tt, col1, raw[1]);
    load_taps(proj, row0, T, tt, col2, raw[2]);
    if (t8 < 32) {
      const int tt2 = dir ? ts + 31 - t8 : ts + t8;
      c_dt = ctrl[(size_t)(row0 + tt2) * 48 + dir * 8 + h];
    }
  }
  __syncthreads();
  for (int c = 0; c < nc; c++) {
    const int ts = (dir ? nc - 1 - c : c) << 5;
#pragma unroll
    for (int r = 0; r < 16; r++) h0b[(pt * 32 + crow32(r, hi)) * 72 + nt * 32 + m32] = f2bf(Hacc[r]);
    if (t8 < 32) {
      const float dt = softplusf_(c_dt + dtb);
      const float la = dt * a_ssm;
      const float ac = prefix32(la, t8);
      const float ac_end = __shfl(ac, 31, 64);
      dtl[t8] = dt;
      acl[t8] = ac;
      eal[t8] = __expf(ac);
      wl[t8] = __expf(ac_end - ac) * dt;
    }
    __syncthreads();
    {
      const float wsc = wl[s_ld];
      float o[8];
      conv_lds(raw[0], cwl, dc, o);
#pragma unroll
      for (int i = 0; i < 8; i++) o[i] = siluf_(o[i]);
      *(float4*)(xl + s_ld * 64 + dc * 8) = make_float4(o[0], o[1], o[2], o[3]);
      *(float4*)(xl + s_ld * 64 + dc * 8 + 4) = make_float4(o[4], o[5], o[6], o[7]);
#pragma unroll
      for (int i = 0; i < 8; i += 2) {
        const unsigned pk = pack2(o[i], o[i + 1]), pw = pack2(o[i] * wsc, o[i + 1] * wsc);
        xT[(dc * 8 + i) * 40 + s_ld] = (bfu)(pk & 0xffff);
        xT[(dc * 8 + i + 1) * 40 + s_ld] = (bfu)(pk >> 16);
        xwT[(dc * 8 + i) * 40 + s_ld] = (bfu)(pw & 0xffff);
        xwT[(dc * 8 + i + 1) * 40 + s_ld] = (bfu)(pw >> 16);
      }
      conv_lds(raw[1], cwl + 320, dc, o);
#pragma unroll
      for (int i = 0; i < 8; i++) o[i] = siluf_(o[i]);
      {
        const uint4 pb = pack8(o);
        *(uint4*)(bbf + s_ld * 72 + dc * 8) = pb;
        bT[(dc * 8 + 0) * 40 + s_ld] = (bfu)(pb.x & 0xffff); bT[(dc * 8 + 1) * 40 + s_ld] = (bfu)(pb.x >> 16);
        bT[(dc * 8 + 2) * 40 + s_ld] = (bfu)(pb.y & 0xffff); bT[(dc * 8 + 3) * 40 + s_ld] = (bfu)(pb.y >> 16);
        bT[(dc * 8 + 4) * 40 + s_ld] = (bfu)(pb.z & 0xffff); bT[(dc * 8 + 5) * 40 + s_ld] = (bfu)(pb.z >> 16);
        bT[(dc * 8 + 6) * 40 + s_ld] = (bfu)(pb.w & 0xffff); bT[(dc * 8 + 7) * 40 + s_ld] = (bfu)(pb.w >> 16);
      }
      conv_lds(raw[2], cwl + 640, dc, o);
#pragma unroll
      for (int i = 0; i < 8; i++) o[i] = siluf_(o[i]);
      *(uint4*)(cbf + s_ld * 72 + dc * 8) = pack8(o);
    }
    __syncthreads();
    if (c + 1 < nc) {
      const int ts2 = (dir ? nc - 2 - c : c + 1) << 5;
      const int tt = dir ? ts2 + 31 - s_ld : ts2 + s_ld;
      load_taps(proj, row0, T, tt, col0, raw[0]);
      load_taps(proj, row0, T, tt, col1, raw[1]);
      load_taps(proj, row0, T, tt, col2, raw[2]);
      if (t8 < 32) {
        const int tt2 = dir ? ts2 + 31 - t8 : ts2 + t8;
        c_dt = ctrl[(size_t)(row0 + tt2) * 48 + dir * 8 + h];
      }
    }
    {
      const float dtot = eal[31];
#pragma unroll
      for (int r = 0; r < 16; r++) Hacc[r] *= dtot;
#pragma unroll
      for (int jj = 0; jj < 2; jj++) {
        const bf16x8 a = *(const bf16x8*)(xwT + (pt * 32 + m32) * 40 + jj * 16 + hi * 8);
        const bf16x8 bb = *(const bf16x8*)(bT + (nt * 32 + m32) * 40 + jj * 16 + hi * 8);
        Hacc = MFMA32(a, bb, Hacc);
      }
    }
    bfu* mysc = scb + (wv & 1) * 1280;
    if (wv < 2) {
      f32x16 acc;
#pragma unroll
      for (int r = 0; r < 16; r++) acc[r] = 0.f;
#pragma unroll
      for (int kk = 0; kk < 4; kk++) {
        const bf16x8 a = *(const bf16x8*)(cbf + m32 * 72 + kk * 16 + hi * 8);
        const bf16x8 bb = *(const bf16x8*)(bbf + m32 * 72 + kk * 16 + hi * 8);
        acc = MFMA32(a, bb, acc);
      }
      const float aj = acl[m32], dj = dtl[m32];
#pragma unroll
      for (int r = 0; r < 16; r++) {
        const int i = crow32(r, hi);
        const float val = (m32 <= i) ? acc[r] * __expf(acl[i] - aj) * dj : 0.f;
        mysc[i * 40 + m32] = f2bf(val);
      }
    }
    __syncthreads();
    if (wv < 2) {
      const int p0 = wv * 32;
      f32x16 acc;
#pragma unroll
      for (int r = 0; r < 16; r++) acc[r] = 0.f;
#pragma unroll
      for (int kk = 0; kk < 4; kk++) {
        const bf16x8 a = *(const bf16x8*)(cbf + m32 * 72 + kk * 16 + hi * 8);
        const bf16x8 bb = *(const bf16x8*)(h0b + (p0 + m32) * 72 + kk * 16 + hi * 8);
        acc = MFMA32(a, bb, acc);
      }
#pragma unroll
      for (int r = 0; r < 16; r++) acc[r] *= eal[crow32(r, hi)];
#pragma unroll
      for (int jj = 0; jj < 2; jj++) {
        const bf16x8 a = *(const bf16x8*)(mysc + m32 * 40 + jj * 16 + hi * 8);
        const bf16x8 bb = *(const bf16x8*)(xT + (p0 + m32) * 40 + jj * 16 + hi * 8);
        acc = MFMA32(a, bb, acc);
      }
#pragma unroll
      for (int r = 0; r < 16; r++) {
        const int i = crow32(r, hi);
        ol[i * 64 + p0 + m32] = acc[r] + Dh * xl[i * 64 + p0 + m32];
      }
    }
    __syncthreads();
    scan_out(ol, bufy, row0, ts, dir, t8, h * 64, c >= (nc >> 1));
    if (c == (nc >> 1) - 1) __threadfence();
  }
  if (!lat) {
    float* dst = p.out + O_SSM + ((((size_t)b * 2 + l) * 2 + dir) * 8 + h) * 4096;
#pragma unroll
    for (int r = 0; r < 16; r++) dst[(pt * 32 + crow32(r, hi)) * 64 + nt * 32 + m32] = Hacc[r];
  }
}

__device__ __forceinline__ void lru_unit(const Params& p, int l, int seq, int k, char* lds) {
  const int tid = tid_(), dir = tid >> 8, t8 = tid & 255;
  const bool lat = seq >= 16;
  const int b = lat ? seq - 16 : seq, T = lat ? 2048 : 256, row0 = lat ? NCTX + b * 2048 : b * 256;
  char* dbase = lds + dir * 59776;
  bfu* wT = (bfu*)dbase;
  float* xl = (float*)(dbase + 18432);
  bfu* xb = (bfu*)(dbase + 26624);
  float* gl = (float*)(dbase + 31232);
  float* ol = (float*)(dbase + 47616);
  float* cA = (float*)(dbase + 55808), *cU = (float*)(dbase + 56832), *carry = (float*)(dbase + 57856);
  float* cwl = (float*)(dbase + 58112);
  const bfu* proj = ws_bf(p, WS_PROJ);
  bfu* bufy = ws_bf(p, WS_BUFY) + (size_t)2 * NTOK * 512;
  const int e = t8 & 63, tq = t8 >> 6;
  const int s_ld = t8 >> 3, dc = t8 & 7;
  const int wv = t8 >> 6, lane = t8 & 63, m32 = lane & 31, hi = lane >> 5;
  __syncthreads();
  {
    const float* wa = p.in[I_LWA] + (size_t)((l * 2 + dir) * 8 + k) * 4096;
    const float* wi = p.in[I_LWI] + (size_t)((l * 2 + dir) * 8 + k) * 4096;
    for (int i = t8; i < 4096; i += 256) {
      const int d = i >> 6, ee = i & 63;
      wT[ee * 72 + d] = f2bf(wa[i]);
      wT[(64 + ee) * 72 + d] = f2bf(wi[i]);
    }
    if (t8 < 64) carry[t8] = lat ? p.in[I_SLRU][(((size_t)b * 2 + l) * 2 + dir) * 512 + k * 64 + t8] : 0.f;
    const float* cw = p.in[I_LCW] + (size_t)l * 4 * 512;
    const float* cb = p.in[I_LCB] + (size_t)l * 512;
    for (int i = t8; i < 320; i += 256) {
      int j = i >> 6, d = i & 63;
      cwl[i] = (j < 4) ? cw[j * 512 + k * 64 + d] : cb[k * 64 + d];
    }
  }
  const int ecol = wv * 32 + m32;
  const float gbias = (ecol < 64) ? p.in[I_LBA][(l * 2 + dir) * 512 + k * 64 + ecol]
                                  : p.in[I_LBI][(l * 2 + dir) * 512 + k * 64 + (ecol - 64)];
  const float sp = softplusf_(-p.in[I_LLAM][(l * 2 + dir) * 512 + k * 64 + e]);
  const int nc = T >> 5;
  uint4 raw[4];
  {
    const int ts = (dir ? nc - 1 : 0) << 5;
    const int tt = dir ? ts + 31 - s_ld : ts + s_ld;
    load_taps(proj, row0, T, tt, C_XD + k * 64 + dc * 8, raw);
  }
  __syncthreads();
  for (int c = 0; c < nc; c++) {
    const int ts = (dir ? nc - 1 - c : c) << 5;
    {
      float o[8];
      conv_lds(raw, cwl, dc, o);
      float* dst = xl + s_ld * 64 + dc * 8;
      *(float4*)dst = make_float4(o[0], o[1], o[2], o[3]);
      *(float4*)(dst + 4) = make_float4(o[4], o[5], o[6], o[7]);
      *(uint4*)(xb + s_ld * 72 + dc * 8) = pack8(o);
    }
    __syncthreads();
    if (c + 1 < nc) {
      const int ts2 = (dir ? nc - 2 - c : c + 1) << 5;
      const int tt = dir ? ts2 + 31 - s_ld : ts2 + s_ld;
      load_taps(proj, row0, T, tt, C_XD + k * 64 + dc * 8, raw);
    }
    {
      f32x16 acc;
#pragma unroll
      for (int r = 0; r < 16; r++) acc[r] = 0.f;
#pragma unroll
      for (int kk = 0; kk < 4; kk++) {
        const bf16x8 a = *(const bf16x8*)(xb + m32 * 72 + kk * 16 + hi * 8);
        const bf16x8 bb = *(const bf16x8*)(wT + ecol * 72 + kk * 16 + hi * 8);
        acc = MFMA32(a, bb, acc);
      }
#pragma unroll
      for (int r = 0; r < 16; r++) gl[crow32(r, hi) * 128 + ecol] = sigmoidf_(acc[r] + gbias);
    }
    __syncthreads();
    float av[8], uv[8];
    float Ac = 1.f, Uc = 0.f;
#pragma unroll
    for (int i = 0; i < 8; i++) {
      const int s = tq * 8 + i;
      const float r = gl[s * 128 + e], ig = gl[s * 128 + 64 + e];
      float la = -8.f * r * sp;
      float a = __expf(la);
      float u = sqrtf(fmaxf(1.f - a * a, 0.f)) * ig * xl[s * 64 + e];
      av[i] = a; uv[i] = u;
      Uc = a * Uc + u;
      Ac *= a;
    }
    cA[tq * 64 + e] = Ac;
    cU[tq * 64 + e] = Uc;
    __syncthreads();
    float hh = carry[e];
    for (int q = 0; q < tq; q++) hh = cA[q * 64 + e] * hh + cU[q * 64 + e];
#pragma unroll
    for (int i = 0; i < 8; i++) {
      hh = av[i] * hh + uv[i];
      ol[(tq * 8 + i) * 64 + e] = hh;
    }
    __syncthreads();
    if (tq == 3) carry[e] = hh;
    scan_out(ol, bufy, row0, ts, dir, t8, k * 64, c >= (nc >> 1));
    if (c == (nc >> 1) - 1) __threadfence();
  }
  __syncthreads();
  if (!lat && t8 < 64) p.out[O_LRU + (((size_t)b * 2 + l) * 2 + dir) * 512 + k * 64 + t8] = carry[t8];
}


__device__ __forceinline__ void attn_tile(const char* Kl, const bfu* Vt, int lane, int lq, int sw, const bf16x8 (&qf)[2],
                                          f32x4 (&O)[4], float& m, float& lsum) {
    f32x4 sc[4];
#pragma unroll
    for (int st = 0; st < 4; st++) {
      sc[st] = f32x4{0.f, 0.f, 0.f, 0.f};
#pragma unroll
      for (int s = 0; s < 2; s++) {
        bf16x8 kf = *(const bf16x8*)(Kl + (st * 16 + (lane & 15)) * 128 + (((s * 4 + lq) ^ sw) << 4));
        sc[st] = __builtin_amdgcn_mfma_f32_16x16x32_bf16(kf, qf[s], sc[st], 0, 0, 0);
      }
    }
    float mx = -1e30f;
#pragma unroll
    for (int st = 0; st < 4; st++)
#pragma unroll
      for (int j = 0; j < 4; j++) { sc[st][j] *= 0.125f; mx = fmaxf(mx, sc[st][j]); }
    mx = fmaxf(mx, __shfl_xor(mx, 16, 64));
    mx = fmaxf(mx, __shfl_xor(mx, 32, 64));
    const float mn = fmaxf(m, mx);
    const float corr = __expf(m - mn);
    m = mn;
    lsum *= corr;
#pragma unroll
    for (int i = 0; i < 4; i++)
#pragma unroll
      for (int j = 0; j < 4; j++) O[i][j] *= corr;
    float ps = 0.f;
#pragma unroll
    for (int st = 0; st < 4; st++)
#pragma unroll
      for (int j = 0; j < 4; j++) { sc[st][j] = __expf(sc[st][j] - mn); ps += sc[st][j]; }
    lsum += ps;
#pragma unroll
    for (int s2 = 0; s2 < 2; s2++) {
      union { uint4 u; bf16x8 v; } pf;
      pf.u.x = pack2(sc[2 * s2][0], sc[2 * s2][1]); pf.u.y = pack2(sc[2 * s2][2], sc[2 * s2][3]);
      pf.u.z = pack2(sc[2 * s2 + 1][0], sc[2 * s2 + 1][1]); pf.u.w = pack2(sc[2 * s2 + 1][2], sc[2 * s2 + 1][3]);
#pragma unroll
      for (int ds = 0; ds < 4; ds++) {
        const bfu* vr = Vt + (ds * 16 + (lane & 15)) * 68;
        union { uint2 u2[2]; bf16x8 v; } vf;
        vf.u2[0] = *(const uint2*)(vr + (2 * s2) * 16 + lq * 4);
        vf.u2[1] = *(const uint2*)(vr + (2 * s2 + 1) * 16 + lq * 4);
        O[ds] = __builtin_amdgcn_mfma_f32_16x16x32_bf16(vf.v, pf.v, O[ds], 0, 0, 0);
      }
    }
}

__device__ __forceinline__ void attn_unit(const Params& p, int l, int lat, int b, int h, int qb, char* lds, bool dry) {
  const int tid = tid_(), lane = tid & 63, w = tid >> 6;
  const int T = lat ? 2048 : 256, row0 = lat ? NCTX + b * 2048 : b * 256;
  const int kvh = h >> 2;
  const int nkt = lat ? 36 : 4;
  bfu* proj = ws_bf(p, WS_PROJ);
  char* Kl = lds;
  bfu* Vt = (bfu*)(lds + 8192);
  const int qrow = row0 + qb * 128 + w * 16 + (lane & 15);
  const int lq = lane >> 4;
  bf16x8 qf[2];
  qf[0] = *(const bf16x8*)(proj + (size_t)qrow * LDP + C_QB + h * 64 + lq * 8);
  qf[1] = *(const bf16x8*)(proj + (size_t)qrow * LDP + C_QB + h * 64 + 32 + lq * 8);
  f32x4 O[4];
#pragma unroll
  for (int i = 0; i < 4; i++) O[i] = f32x4{0.f, 0.f, 0.f, 0.f};
  float m = -1e30f, lsum = 0.f;
  const int key = tid >> 3, ch = tid & 7;
  const int sw = (lane & 15) >> 1;
  u32x4 rkA, rvA, rkB, rvB;
#define ATT_LOAD(RK, RV, KT)                                                                              \
  {                                                                                                       \
    const int kt_ = (KT);                                                                                 \
    if (lat && kt_ < 4) {                                                                                 \
      size_t idx = ((((size_t)b * 2 + l) * 256 + kt_ * 64 + key) * 2 + kvh) * 64 + ch * 8;               \
      const float* ck = p.in[I_CK] + idx;                                                                 \
      const float* cv = p.in[I_CV] + idx;                                                                 \
      float4 a0 = *(const float4*)ck, a1 = *(const float4*)(ck + 4);                                      \
      float4 b0 = *(const float4*)cv, b1 = *(const float4*)(cv + 4);                                      \
      RK = u32x4{pack2(a0.x, a0.y), pack2(a0.z, a0.w), pack2(a1.x, a1.y), pack2(a1.z, a1.w)};            \
      RV = u32x4{pack2(b0.x, b0.y), pack2(b0.z, b0.w), pack2(b1.x, b1.y), pack2(b1.z, b1.w)};            \
    } else {                                                                                              \
      int tk = (kt_ - (lat ? 4 : 0)) * 64 + key;                                                          \
      const bfu* pr = proj + (size_t)(row0 + tk) * LDP;                                                   \
      RK = *(const u32x4*)(pr + C_KB + kvh * 64 + ch * 8);                                                \
      RV = *(const u32x4*)(pr + C_VB + kvh * 64 + ch * 8);                                                \
    }                                                                                                     \
  }
#define ATT_STEP(RK, RV, KT)                                                                              \
  {                                                                                                       \
    *(u32x4*)(Kl + key * 128 + ((ch ^ ((key >> 1) & 7)) << 4)) = RK;                                     \
    {                                                                                                     \
      bfu* vd = Vt + (ch * 8) * 68 + key;                                                                 \
      vd[0 * 68] = (bfu)(RV.x & 0xffff); vd[1 * 68] = (bfu)(RV.x >> 16);                                  \
      vd[2 * 68] = (bfu)(RV.y & 0xffff); vd[3 * 68] = (bfu)(RV.y >> 16);                                  \
      vd[4 * 68] = (bfu)(RV.z & 0xffff); vd[5 * 68] = (bfu)(RV.z >> 16);                                  \
      vd[6 * 68] = (bfu)(RV.w & 0xffff); vd[7 * 68] = (bfu)(RV.w >> 16);                                  \
    }                                                                                                     \
    __syncthreads();                                                                                      \
    if ((KT) + 2 < nkt) ATT_LOAD(RK, RV, (KT) + 2);                                                       \
    attn_tile(Kl, Vt, lane, lq, sw, qf, O, m, lsum);                                                      \
    __syncthreads();                                                                                      \
  }
  __syncthreads();
  ATT_LOAD(rkA, rvA, 0);
  ATT_LOAD(rkB, rvB, 1);
  for (int kt = 0; kt < nkt; kt += 2) {
    ATT_STEP(rkA, rvA, kt);
    ATT_STEP(rkB, rvB, kt + 1);
  }
#undef ATT_LOAD
#undef ATT_STEP
  lsum += __shfl_xor(lsum, 16, 64);
  lsum += __shfl_xor(lsum, 32, 64);
  const float inv = 1.f / lsum;
  if (!dry || lsum < 0.f)
#pragma unroll
  for (int ds = 0; ds < 4; ds++) {
    uint2 pk;
    pk.x = pack2(O[ds][0] * inv, O[ds][1] * inv);
    pk.y = pack2(O[ds][2] * inv, O[ds][3] * inv);
    *(uint2*)(proj + (size_t)qrow * LDP + C_QB + h * 64 + ds * 16 + lq * 4) = pk;
  }
}

__device__ __forceinline__ void phase_mixers(const Params& p, int l, char* lds, int rep) {
  __shared__ int s_unit;
  {
  int* ctr = (int*)(p.ws + WS_CTR) + l + 2 * rep;
  const int NU = (rep == 1 || rep >= 4) ? 576 : 1856;
  const bool dry_ = rep >= 2;
  while (true) {
    __syncthreads();
    if (tid_() == 0) s_unit = atomicAdd(ctr, 1);
    __syncthreads();
    const int u = s_unit + (rep == 2 ? 576 : 0);
    if (u >= NU) break;
    if (rep >= 4) {
      const int typ = (u < 64) ? 0 : (u < 128) ? 1 : (u < 192) ? 2 : (u < 320) ? 0 : (u < 448) ? 1 : 2;
      if (typ != rep - 4) continue;
    }
    if (u < 64) delta_unit(p, l, 16 + (u >> 3), u & 7, lds);
    else if (u < 128) ssd_unit(p, l, 16 + ((u - 64) >> 3), (u - 64) & 7, lds);
    else if (u < 192) lru_unit(p, l, 16 + ((u - 128) >> 3), (u - 128) & 7, lds);
    else if (u < 320) delta_unit(p, l, (u - 192) >> 3, (u - 192) & 7, lds);
    else if (u < 448) ssd_unit(p, l, (u - 320) >> 3, (u - 320) & 7, lds);
    else if (u < 576) lru_unit(p, l, (u - 448) >> 3, (u - 448) & 7, lds);
    else if (u < 1600) { int a = u - 576; attn_unit(p, l, 1, a >> 7, (a >> 4) & 7, a & 15, lds, dry_); }
    else { int a = u - 1600; attn_unit(p, l, 0, a >> 4, (a >> 1) & 7, a & 1, lds, dry_); }
  }
  }
}

__device__ __forceinline__ void phase_branch_norm(const Params& p, int l) {
  const int lane = tid_() & 63, w = tid_() >> 6;
  bfu* proj = ws_bf(p, WS_PROJ);
  const bfu* by = ws_bf(p, WS_BUFY);
  const int c0 = lane * 8;
  float gs[8], gd[8];
#pragma unroll
  for (int i = 0; i < 8; i++) { gs[i] = p.in[I_SNORM][l * 512 + c0 + i]; gd[i] = p.in[I_DNORM][l * 64 + ((c0 + i) & 63)]; }
  for (int row = blockIdx.x * 8 + w; row < NTOK; row += gridDim.x * 8) {
    bfu* pr = proj + (size_t)row * LDP;
    float y[8], z[8], o[8];
    unpack8(*(const uint4*)(by + (size_t)row * 512 + c0), y);
    unpack8(*(const uint4*)(pr + C_Z + c0), z);
    float ss = 0.f;
#pragma unroll
    for (int i = 0; i < 8; i++) { y[i] = y[i] * siluf_(z[i]); ss += y[i] * y[i]; }
    ss = wave_sum(ss);
    float r = rsqrtf(ss * (1.f / 512.f) + 1e-6f);
#pragma unroll
    for (int i = 0; i < 8; i++) o[i] = y[i] * r * gs[i];
    *(uint4*)(pr + C_Z + c0) = pack8(o);
    unpack8(*(const uint4*)(by + (size_t)(NTOK + row) * 512 + c0), y);
    unpack8(*(const uint4*)(pr + C_GC + c0), z);
    ss = 0.f;
#pragma unroll
    for (int i = 0; i < 8; i++) ss += y[i] * y[i];
    ss = DPP_ADD(ss, 0xB1); ss = DPP_ADD(ss, 0x4E); ss = DPP_ADD(ss, 0x141);
    r = rsqrtf(ss * (1.f / 64.f) + 1e-6f);
#pragma unroll
    for (int i = 0; i < 8; i++) o[i] = y[i] * r * gd[i] * siluf_(z[i]);
    *(uint4*)(pr + C_GC + c0) = pack8(o);
    unpack8(*(const uint4*)(by + (size_t)(2 * NTOK + row) * 512 + c0), y);
    unpack8(*(const uint4*)(pr + C_YD + c0), z);
#pragma unroll
    for (int i = 0; i < 8; i++) o[i] = y[i] * gelu_tanh(z[i]);
    *(uint4*)(pr + C_YD + c0) = pack8(o);
  }
}

constexpr int NPHASE = 28;

__device__ __forceinline__ void run_phase(const Params& p, int ph, char* lds) {
  if (ph == 0) {
    if (blockIdx.x == 0) { for (int i = tid_(); i < 1024; i += NTHREADS) ((int*)(p.ws + WS_CTR))[i] = 0; }
    phase_rope_table(p);
    phase_mods(p, lds);
  }
  if (ph == NPHASE - 1) { phase_final_norm(p); return; }
  const int l = (ph - 1) / 13, s = (ph == 0) ? 0 : (ph - 1) % 13;
  if (s == 0 || s == 3 || s == 10) {
    if (ph != 0) phase_norm(p, l, s == 0 ? 0 : (s == 3 ? 1 : 2), s == 0 && l == 0);
#ifdef REP_NORM
    if (ph != 0) { for (int r = 0; r < 2; r++) phase_norm(p, l, s == 0 ? 0 : (s == 3 ? 1 : 2), s == 0 && l == 0); }
#endif
    int jlo = 0, jhi = 0, cl = 1;
    if (ph == 0) { jlo = 0; jhi = 11; cl = 0; }
    if (s == 0 && l == 1) { jlo = 2; jhi = 11; }
    if (s == 3 && l == 0) { jlo = 0; jhi = 2; }
    if (jhi > jlo) { __syncthreads(); convert_jobs(p, cl, jlo, jhi, lds); }
  } else if (s == 1 || s == 11) {
    for (int r = 0; r < REP_GEMM; r++) phase_gemm_w13(p, s == 1 ? WS_W13A : WS_W13B, lds);
  } else if (s == 2 || s == 9 || s == 12) {
    const bfu* A = ws_bf(p, WS_PROJ) + (s == 9 ? C_MRG : 0);
    const int lda = (s == 9) ? LDP : DFF, K = (s == 9) ? 1024 : DFF;
    const size_t wo = (s == 2) ? WS_W2A : (s == 9 ? WS_WOUT : WS_W2B);
    const int midx = (s == 2) ? 2 : (s == 9 ? 5 : 8);
#ifdef REP_RES
    for (int r = 0; r < 2; r++)
    phase_gemm_res(p, l, A, lda, K, wo, midx, s == 9 ? 1.0f : 0.5f, s == 2 && l == 0, lds, r == 0);
#else
    phase_gemm_res(p, l, A, lda, K, wo, midx, s == 9 ? 1.0f : 0.5f, s == 2 && l == 0, lds);
#endif
  } else if (s == 4) { for (int r = 0; r < REP_GEMM; r++) phase_gemm_win(p, lds); }
  else if (s == 5) phase_prep(p, l);
  else if (s == 6) phase_mixers(p, l, lds, 0);
  else if (s == 7) phase_branch_norm(p, l);
  else if (s == 8) { for (int r = 0; r < REP_GEMM; r++) phase_gemm_merge(p, lds); }
}

#define XB_TMO      128
#define XB_XCNT(j)  (256  + 64 * (j))
#define XB_XSUB(j)  (1280 + 64 * (j))
#define XB_XGEN(j)  (2304 + 64 * (j))
#define XB_TOP      3328
#define XB_TOPGEN   3392
#define XCD_BAR_WORDS 3456
#define XB_SPIN_CAP (1u << 18)
#define LAS __attribute__((address_space(3)))

__device__ __forceinline__ unsigned xb_ld(unsigned* p)              { return __hip_atomic_load(p, __ATOMIC_RELAXED, __HIP_MEMORY_SCOPE_AGENT); }
__device__ __forceinline__ unsigned xb_add(unsigned* p, unsigned v) { return __hip_atomic_fetch_add(p, v, __ATOMIC_RELAXED, __HIP_MEMORY_SCOPE_AGENT); }
__device__ __forceinline__ unsigned xb_xcc_id() { return (unsigned)__builtin_amdgcn_s_getreg((3 << 11) | 20) & 0xFu; }
#define XB_SPIN(cond, bar) do { unsigned _sp = 0; while (cond) { __builtin_amdgcn_s_sleep(1); \
    if ((++_sp & 255u) == 0u) { if (xb_ld(&(bar)[XB_TMO])) break; if (_sp > XB_SPIN_CAP) { atomicAdd(&(bar)[XB_TMO], 1u); break; } } } } while (0)

struct XcdBarrier {
    unsigned* bar; unsigned x;
    volatile LAS unsigned* st;
};

__device__ __forceinline__ XcdBarrier xcd_barrier_post(unsigned* bar, volatile LAS unsigned* st) {
    XcdBarrier b; b.bar = bar; b.x = xb_xcc_id(); b.st = st;
    if (threadIdx.x == 0) (void)xb_add(&bar[XB_XCNT(b.x)], 1u);
    return b;
}
__device__ __forceinline__ void xcd_barrier_complete(unsigned* bar, unsigned x, unsigned& nloc, unsigned& nx) {
    const unsigned G = gridDim.x * gridDim.y * gridDim.z;
    unsigned sum, cnt, mine, sp = 0u;
    for (;;) {
        sum = 0u; cnt = 0u; mine = 0u;
#pragma unroll
        for (unsigned j = 0; j < 16; ++j) { const unsigned c = xb_ld(&bar[XB_XCNT(j)]); sum += c; cnt += (c > 0u) ? 1u : 0u; mine = (j == x) ? c : mine; }
        if (sum == G) break;
        __builtin_amdgcn_s_sleep(1);
        if ((++sp & 255u) == 0u) { if (xb_ld(&bar[XB_TMO])) break; if (sp > XB_SPIN_CAP) { atomicAdd(&bar[XB_TMO], 1u); break; } }
    }
    nloc = mine > 0u ? mine : 1u; nx = cnt > 0u ? cnt : 1u;
}

__device__ __forceinline__ void xcd_barrier(const XcdBarrier& b) {
    asm volatile("s_waitcnt vmcnt(0)" ::: "memory");
    __syncthreads();
    if (threadIdx.x == 0) {
        unsigned* bar = b.bar;
        __builtin_amdgcn_s_waitcnt(0);
        unsigned nloc = b.st[0], nx = b.st[1];
        if (nloc == 0u) { xcd_barrier_complete(bar, b.x, nloc, nx); b.st[0] = nloc; b.st[1] = nx; }
        const unsigned old = xb_add(&bar[XB_XSUB(b.x)], 1u);
        const unsigned gen = old / nloc;
        if (old + 1u == (gen + 1u) * nloc) {
            __builtin_amdgcn_fence(__ATOMIC_RELEASE, "agent");
            asm volatile("s_waitcnt vmcnt(0)" ::: "memory");
            const unsigned og = xb_add(&bar[XB_TOP], 1u);
            const unsigned tg = og / nx;
            if (og + 1u == (tg + 1u) * nx) xb_add(&bar[XB_TOPGEN], 1u);
            else XB_SPIN(xb_ld(&bar[XB_TOPGEN]) == tg, bar);
            __builtin_amdgcn_fence(__ATOMIC_ACQUIRE, "agent");
            xb_add(&bar[XB_XGEN(b.x)], 1u);
            asm volatile("s_waitcnt vmcnt(0)" ::: "memory");
        } else {
            XB_SPIN(xb_ld(&bar[XB_XGEN(b.x)]) == gen, bar);
            __builtin_amdgcn_fence(__ATOMIC_ACQUIRE, "agent");
            asm volatile("s_waitcnt vmcnt(0)" ::: "memory");
        }
    }
    __syncthreads();
}


__device__ __forceinline__ void gbar(unsigned* bar, unsigned k) {
  asm volatile("s_waitcnt vmcnt(0)" ::: "memory");
  __syncthreads();
  if (threadIdx.x == 0) {
    __builtin_amdgcn_fence(__ATOMIC_RELEASE, "agent");
    asm volatile("s_waitcnt vmcnt(0)" ::: "memory");
    const unsigned g = blockIdx.x & 7u;
    const unsigned ng = (gridDim.x - g + 7u) >> 3;
    const unsigned old = __hip_atomic_fetch_add(bar + g * 64, 1u, __ATOMIC_RELAXED, __HIP_MEMORY_SCOPE_AGENT);
    if (old + 1u == k * ng) {
      const unsigned ngroups = gridDim.x < 8u ? gridDim.x : 8u;
      const unsigned o2 = __hip_atomic_fetch_add(bar + 8 * 64, 1u, __ATOMIC_RELAXED, __HIP_MEMORY_SCOPE_AGENT);
      if (o2 + 1u == k * ngroups) __hip_atomic_fetch_add(bar + 9 * 64, 1u, __ATOMIC_RELAXED, __HIP_MEMORY_SCOPE_AGENT);
    }
    while (__hip_atomic_load(bar + 9 * 64, __ATOMIC_RELAXED, __HIP_MEMORY_SCOPE_AGENT) < k) __builtin_amdgcn_s_sleep(1);
    __builtin_amdgcn_fence(__ATOMIC_ACQUIRE, "agent");
    asm volatile("s_waitcnt vmcnt(0)" ::: "memory");
  }
  __syncthreads();
}

__global__ void __launch_bounds__(NTHREADS) mega(Params p, int ph_lo, int ph_hi) {
  extern __shared__ __attribute__((aligned(16))) char lds[];
  cg::grid_group grid = cg::this_grid();
  __shared__ uint4 xb_words;
  if (threadIdx.x == 0) xb_words = make_uint4(0u, 0u, 0u, 0u);
  __syncthreads();
  const XcdBarrier xb = xcd_barrier_post((unsigned*)(p.ws + WS_XBAR), (volatile LAS unsigned*)&xb_words);
  for (int ph = ph_lo; ph < ph_hi; ph++) {
    run_phase(p, ph, lds);
#ifdef REP_P0
    if (ph == 0) { __syncthreads(); run_phase(p, ph, lds); }
#endif
#ifdef REP_TYPE
    if (ph >= 1 && ph < NPHASE - 1 && (ph - 1) % 13 == 6) { grid.sync(); phase_mixers(p, (ph - 1) / 13, lds, 4 + REP_TYPE); }
#endif
#ifdef REP_MIX
    if (ph >= 1 && ph < NPHASE - 1 && (ph - 1) % 13 == 6) { grid.sync(); phase_mixers(p, (ph - 1) / 13, lds, 3); }
#endif
#ifdef REP_ATTN
    if (ph >= 1 && ph < NPHASE - 1 && (ph - 1) % 13 == 6) { grid.sync(); phase_mixers(p, (ph - 1) / 13, lds, 2); }
#endif
#if REP_SCAN > 1
    if (ph >= 1 && ph < NPHASE - 1 && (ph - 1) % 13 == 6) { grid.sync(); phase_mixers(p, (ph - 1) / 13, lds, 1); }
#endif
    if (ph + 1 < ph_hi) {
      if (ph_hi < 0) grid.sync();
      xcd_barrier(xb);
    }
  }
}

extern "C" void kernel_launch(void* const* d_in, const int* in_sizes, int n_in, void* d_out, int out_size, void* d_ws,
                              size_t ws_size, hipStream_t stream) {
  static int grid_blocks = 0;
  if (grid_blocks == 0) {
    if (n_in != 42 || ws_size < WS_END) {
      fprintf(stderr, "kernel_launch: unexpected n_in %d or ws_size %zu (need %zu)\n", n_in, ws_size, (size_t)WS_END);
      grid_blocks = -1;
      return;
    }
    int dev = 0, cus = 0, per_cu = 0;
    (void)hipGetDevice(&dev);
    (void)hipDeviceGetAttribute(&cus, hipDeviceAttributeMultiprocessorCount, dev);
    (void)hipFuncSetAttribute((const void*)mega, hipFuncAttributeMaxDynamicSharedMemorySize, LDS_BYTES);
    (void)hipOccupancyMaxActiveBlocksPerMultiprocessor(&per_cu, (const void*)mega, NTHREADS, LDS_BYTES);
    if (per_cu < 1) { fprintf(stderr, "kernel_launch: occupancy query returned %d\n", per_cu); per_cu = 1; }
    grid_blocks = cus;
  }
  if (grid_blocks < 0) return;
  Params p{};
  for (int i = 0; i < 42; i++) p.in[i] = (const float*)d_in[i];
  p.out = (float*)d_out;
  p.ws = (char*)d_ws;
  (void)hipMemsetAsync((char*)d_ws + WS_XBAR, 0, XCD_BAR_WORDS * sizeof(unsigned), stream);
  int lo = 0, hi = NPHASE;
  void* args[] = {&p, &lo, &hi};
  hipError_t e = hipLaunchCooperativeKernel((const void*)mega, dim3(grid_blocks), dim3(NTHREADS), args, LDS_BYTES, stream);
  if (e != hipSuccess) fprintf(stderr, "cooperative launch failed: %s (grid %d)\n", hipGetErrorString(e), grid_blocks);
}

#ifdef RES_TEST
#define TK(name, body) __global__ void __launch_bounds__(NTHREADS) name(Params p, int l) { extern __shared__ __attribute__((aligned(16))) char lds[]; body; }
TK(t_mods, phase_mods(p, lds))
TK(t_cvt, convert_jobs(p, l, 0, 11, lds))
TK(t_norm, phase_norm(p, l, 0, l == 0))
TK(t_w13, phase_gemm_w13(p, WS_W13A, lds))
TK(t_res, phase_gemm_res(p, l, ws_bf(p, WS_PROJ), DFF, DFF, WS_W2A, 2, 0.5f, l == 0, lds))
TK(t_win, phase_gemm_win(p, lds))
TK(t_prep, phase_prep(p, l))
TK(t_delta, delta_unit(p, l, l, 3, lds))
TK(t_ssd, ssd_unit(p, l, l, 3, lds))
TK(t_lru, lru_unit(p, l, l, 3, lds))
TK(t_attn, attn_unit(p, l, l & 1, 2, 3, 1, lds, false))
TK(t_bn, phase_branch_norm(p, l))
TK(t_merge, phase_gemm_merge(p, lds))
#endif
```

```cpp
#include <hip/hip_runtime.h>
#include <hip/hip_bf16.h>
#include <hip/hip_cooperative_groups.h>
#include <cstdio>
namespace cg = cooperative_groups;

typedef __attribute__((ext_vector_type(8))) short bf16x8;
typedef __attribute__((ext_vector_type(4))) float f32x4;
typedef unsigned short bfu;

constexpr int NTOK = 20480, NCTX = 4096, DM = 1024, DFF = 2816, NINP = 9264, NPROJ = 5168, LDP = 5376;
#ifndef REP_GEMM
#define REP_GEMM 1
#endif
#ifndef REP_SCAN
#define REP_SCAN 1
#endif
constexpr int NTHREADS = 512;
constexpr int LDS_BYTES = 131072;
constexpr int C_Z = 0, C_XBC = 512, C_DT = 1280, C_QB = 1296, C_KB = 1808, C_VB = 1936, C_QC = 2064,
              C_BETA = 3600, C_AC = 3616, C_GC = 3632, C_XD = 4144, C_YD = 4656;
constexpr int C_MRG = 2064;
constexpr size_t O_NK = 20971520, O_NV = 22020096, O_SSM = 23068672, O_DELTA = 25165824, O_LRU = 27262976;
constexpr size_t WS_W13A = 0;
constexpr size_t WS_W2A = WS_W13A + (size_t)5632 * 1024 * 2;
constexpr size_t WS_WIN = WS_W2A + (size_t)1024 * 2816 * 2;
constexpr size_t WS_WG = WS_WIN + (size_t)LDP * 1024 * 2;
constexpr size_t WS_WBR = WS_WG + (size_t)4096 * 1024 * 2;
constexpr size_t WS_WOUT = WS_WBR + (size_t)4 * 1024 * 512 * 2;
constexpr size_t WS_W13B = WS_WOUT + (size_t)1024 * 1024 * 2;
constexpr size_t WS_W2B = WS_W13B + (size_t)5632 * 1024 * 2;
constexpr size_t WS_XN = WS_W2B + (size_t)1024 * 2816 * 2;
constexpr size_t WS_PROJ = WS_XN + (size_t)NTOK * 1024 * 2;
constexpr size_t WS_BUFY = WS_PROJ + (size_t)NTOK * LDP * 2;
constexpr size_t WS_CTRL = WS_BUFY + (size_t)3 * NTOK * 512 * 2;
constexpr size_t WS_MODS = WS_CTRL + (size_t)NTOK * 48 * 4;
constexpr size_t WS_ROPE = WS_MODS + (size_t)2 * 9 * 9216 * 4;
constexpr size_t WS_CTR = WS_ROPE + (size_t)2 * 64 * 16 * 4;
constexpr size_t WS_XBAR = WS_CTR + 4096;
constexpr size_t WS_END = WS_XBAR + 16384;

enum { I_XP = 0, I_XS, I_CK, I_CV, I_SSSM, I_SDELTA, I_SLRU, I_C, I_CCTX, I_WADA, I_BADA, I_NF1, I_F1W13, I_F1W2,
       I_NMIX, I_WIN, I_SCW, I_SCB, I_SALOG, I_SDTB, I_SD, I_SNORM, I_QN, I_KN, I_DCW, I_DCB, I_DALOG, I_DDTB,
       I_DNORM, I_LCW, I_LCB, I_LWA, I_LBA, I_LWI, I_LBI, I_LLAM, I_WBR, I_WOUT, I_NF2, I_F2W13, I_F2W2, I_FN };

struct Params {
  const float* in[42];
  float* out;
  char* ws;
};

__device__ __forceinline__ int tid_() { int t = threadIdx.x; asm volatile("" : "+v"(t)); return t; }
typedef __bf16 bf16x2_t __attribute__((ext_vector_type(2)));
typedef float f32x2_t __attribute__((ext_vector_type(2)));
__device__ __forceinline__ unsigned pack2(float a, float b) {
  f32x2_t v = {a, b};
  bf16x2_t r = __builtin_convertvector(v, bf16x2_t);
  return __builtin_bit_cast(unsigned, r);
}
__device__ __forceinline__ bfu f2bf(float f) { return (bfu)(pack2(f, 0.f) & 0xffffu); }
__device__ __forceinline__ float bf2f(bfu s) { return __uint_as_float(((unsigned)s) << 16); }
__device__ __forceinline__ void unpack8(const uint4& v, float* f) {
  f[0] = __uint_as_float(v.x << 16); f[1] = __uint_as_float(v.x & 0xffff0000u);
  f[2] = __uint_as_float(v.y << 16); f[3] = __uint_as_float(v.y & 0xffff0000u);
  f[4] = __uint_as_float(v.z << 16); f[5] = __uint_as_float(v.z & 0xffff0000u);
  f[6] = __uint_as_float(v.w << 16); f[7] = __uint_as_float(v.w & 0xffff0000u);
}
__device__ __forceinline__ uint4 pack8(const float* f) {
  uint4 v; v.x = pack2(f[0], f[1]); v.y = pack2(f[2], f[3]); v.z = pack2(f[4], f[5]); v.w = pack2(f[6], f[7]);
  return v;
}
__device__ __forceinline__ float sigmoidf_(float x) { return __builtin_amdgcn_rcpf(1.f + __expf(-x)); }
__device__ __forceinline__ float siluf_(float x) { return x * __builtin_amdgcn_rcpf(1.f + __expf(-x)); }
__device__ __forceinline__ float softplusf_(float x) { return fmaxf(x, 0.f) + log1pf(__expf(-fabsf(x))); }
__device__ __forceinline__ float gelu_tanh(float x) {
  float u = 0.7978845608028654f * (x + 0.044715f * x * x * x);
  float t = 1.f - 2.f * __builtin_amdgcn_rcpf(__expf(2.f * u) + 1.f);
  return 0.5f * x * (1.f + t);
}
#define DPP_ADD(v, ctrl) ((v) + __int_as_float(__builtin_amdgcn_update_dpp(0, __float_as_int(v), (ctrl), 0xF, 0xF, true)))
__device__ __forceinline__ float wave_sum(float v) {
  v = DPP_ADD(v, 0xB1);
  v = DPP_ADD(v, 0x4E);
  v = DPP_ADD(v, 0x141);
  v = DPP_ADD(v, 0x140);
  v += __shfl_xor(v, 16, 64);
  v += __shfl_xor(v, 32, 64);
  return v;
}
__device__ __forceinline__ int row_modidx(int row) { return row < NCTX ? 0 : 1 + ((row - NCTX) >> 11); }
__device__ __forceinline__ bfu* ws_bf(const Params& p, size_t off) { return (bfu*)(p.ws + off); }

struct CvtJob { const float* src; bfu* dst; int K, Nsrc, Ndst, mode, coloff, limit; };

__device__ __forceinline__ void cvt_load(const CvtJob& j, int tile, float (&v)[8]) {
  const int nkt = j.K >> 6;
  const int n0 = (tile / nkt) << 6, k0 = (tile % nkt) << 6;
  const int tid = tid_();
  const int ng = tid & 15, kk = tid >> 4;
  const int np = n0 + ng * 4;
  int sc;
  bool valid = true;
  if (j.mode == 1) {
    int blk = np >> 5, w = np & 31;
    sc = (w < 16) ? (blk * 16 + w) : (2816 + blk * 16 + (w - 16));
  } else {
    sc = np + j.coloff;
    valid = np < j.limit;
  }
#pragma unroll
  for (int i = 0; i < 2; i++) {
    float4 t = valid ? *(const float4*)(j.src + (size_t)(k0 + kk + 32 * i) * j.Nsrc + sc) : make_float4(0.f, 0.f, 0.f, 0.f);
    v[i * 4 + 0] = t.x; v[i * 4 + 1] = t.y; v[i * 4 + 2] = t.z; v[i * 4 + 3] = t.w;
  }
}
__device__ __forceinline__ void cvt_store(const CvtJob& j, int tile, const float (&v)[8], char* lds) {
  float* tl = (float*)lds;
  const int nkt = j.K >> 6;
  const int n0 = (tile / nkt) << 6, k0 = (tile % nkt) << 6;
  const int tid = tid_();
  {
    const int ng = tid & 15, kk = tid >> 4;
#pragma unroll
    for (int i = 0; i < 2; i++)
#pragma unroll
      for (int c = 0; c < 4; c++) tl[(kk + 32 * i) * 65 + ng * 4 + c] = v[i * 4 + c];
  }
  __syncthreads();
  {
    const int nn2 = tid >> 3, kc = tid & 7;
    float f[8];
#pragma unroll
    for (int e = 0; e < 8; e++) f[e] = tl[(kc * 8 + e) * 65 + nn2];
    *(uint4*)(j.dst + (size_t)(n0 + nn2) * j.K + k0 + kc * 8) = pack8(f);
  }
  __syncthreads();
}

__device__ __forceinline__ CvtJob get_job(const Params& p, int l, int j) {
  CvtJob r;
  if (j == 0) r = {p.in[I_F1W13] + (size_t)l * 1024 * 5632, ws_bf(p, WS_W13A), 1024, 5632, 5632, 1, 0, 5632};
  else if (j == 1) r = {p.in[I_F1W2] + (size_t)l * 2816 * 1024, ws_bf(p, WS_W2A), 2816, 1024, 1024, 0, 0, 1024};
  else if (j == 2) r = {p.in[I_WIN] + (size_t)l * 1024 * NINP, ws_bf(p, WS_WIN), 1024, NINP, LDP, 0, 0, NPROJ};
  else if (j == 3) r = {p.in[I_WIN] + (size_t)l * 1024 * NINP, ws_bf(p, WS_WG), 1024, NINP, 4096, 0, NPROJ, 4096};
  else if (j < 8) r = {p.in[I_WBR] + (size_t)(l * 4 + (j - 4)) * 512 * 1024, ws_bf(p, WS_WBR) + (size_t)(j - 4) * 1024 * 512, 512, 1024, 1024, 0, 0, 1024};
  else if (j == 8) r = {p.in[I_WOUT] + (size_t)l * 1024 * 1024, ws_bf(p, WS_WOUT), 1024, 1024, 1024, 0, 0, 1024};
  else if (j == 9) r = {p.in[I_F2W13] + (size_t)l * 1024 * 5632, ws_bf(p, WS_W13B), 1024, 5632, 5632, 1, 0, 5632};
  else r = {p.in[I_F2W2] + (size_t)l * 2816 * 1024, ws_bf(p, WS_W2B), 2816, 1024, 1024, 0, 0, 1024};
  return r;
}
__device__ __forceinline__ int job_tiles(int j) {
  return (j == 0 || j == 9) ? 88 * 16 : (j == 1 || j == 10) ? 16 * 44 : (j == 2) ? (LDP / 64) * 16 : (j == 3) ? 64 * 16
         : (j < 8) ? 16 * 8 : 16 * 16;
}

__device__ __forceinline__ bool find_job(const Params& p, int l, int jlo, int jhi, int t, CvtJob& jb, int& tile) {
  int tt = t;
  for (int j = jlo; j < jhi; j++) {
    int n = job_tiles(j);
    if (tt < n) { jb = get_job(p, l, j); tile = tt; return true; }
    tt -= n;
  }
  return false;
}
__device__ __forceinline__ void convert_jobs(const Params& p, int l, int jlo, int jhi, char* lds) {
  CvtJob jc, jn;
  int tc = 0, tn = 0;
  float vc[8], vn[8];
  int t = blockIdx.x;
  bool have = find_job(p, l, jlo, jhi, t, jc, tc);
  if (have) cvt_load(jc, tc, vc);
  while (have) {
    t += gridDim.x;
    const bool have_n = find_job(p, l, jlo, jhi, t, jn, tn);
    if (have_n) cvt_load(jn, tn, vn);
    cvt_store(jc, tc, vc, lds);
    jc = jn; tc = tn; have = have_n;
#pragma unroll
    for (int i = 0; i < 8; i++) vc[i] = vn[i];
  }
}

__device__ __forceinline__ void phase_mods(const Params& p, char* lds) {
  float* sc = (float*)lds;
  float* red = sc + 9 * 1024;
  const int tid = tid_();
  for (int u = blockIdx.x; u < 288; u += gridDim.x) {
    const int l = u / 144, cb = u % 144;
    __syncthreads();
    for (int i = tid; i < 9 * 1024; i += NTHREADS) {
      int ci = i >> 10, k = i & 1023;
      float v = (ci == 0) ? p.in[I_CCTX][k] : p.in[I_C][(ci - 1) * 1024 + k];
      sc[i] = siluf_(v);
    }
    __syncthreads();
    const int col = cb * 64 + (tid & 63), kg = tid >> 6;
    const float* w = p.in[I_WADA] + (size_t)l * 1024 * 9216 + col;
    float a[9];
#pragma unroll
    for (int i = 0; i < 9; i++) a[i] = 0.f;
    for (int k = kg * 128; k < kg * 128 + 128; k++) {
      float wv = w[(size_t)k * 9216];
#pragma unroll
      for (int i = 0; i < 9; i++) a[i] += sc[i * 1024 + k] * wv;
    }
#pragma unroll
    for (int i = 0; i < 9; i++) red[(kg * 9 + i) * 64 + (tid & 63)] = a[i];
    __syncthreads();
    for (int i = tid; i < 9 * 64; i += NTHREADS) {
      int ci = i >> 6, cc = i & 63;
      float s = 0.f;
#pragma unroll
      for (int g = 0; g < 8; g++) s += red[(g * 9 + ci) * 64 + cc];
      int c2 = cb * 64 + cc;
      s += p.in[I_BADA][l * 9216 + c2];
      ((float*)(p.ws + WS_MODS))[(size_t)(l * 9 + ci) * 9216 + c2] = s;
    }
  }
}

__device__ __forceinline__ void sincos_d(double x, float& s, float& c) {
  const double TWO_PI = 6.283185307179586476925287;
  double k = rint(x / TWO_PI);
  double r = x - k * TWO_PI;
  double r2 = r * r;
  double ts = 1.0, tc = 1.0;
  for (int n = 14; n >= 1; n--) {
    ts = 1.0 - r2 / (double)((2 * n) * (2 * n + 1)) * ts;
    tc = 1.0 - r2 / (double)((2 * n - 1) * (2 * n)) * tc;
  }
  s = (float)(r * ts);
  c = (float)tc;
}

__device__ __forceinline__ void phase_rope_table(const Params& p) {
  float* rc = (float*)(p.ws + WS_ROPE);
  float* rs = rc + 1024;
  for (int i = blockIdx.x * NTHREADS + tid_(); i < 1024; i += gridDim.x * NTHREADS) {
    int pos = i >> 4, f = i & 15;
    float inv = powf(10000.f, -(float)f / 16.f);
    float ang = (float)pos * inv;
    float s, c;
    sincos_d((double)ang, s, c);
    rc[i] = c; rs[i] = s;
  }
}

__device__ __forceinline__ void phase_norm(const Params& p, int l, int which, bool first) {
  const int lane = tid_() & 63, w = tid_() >> 6;
  const float* g = p.in[which == 0 ? I_NF1 : (which == 1 ? I_NMIX : I_NF2)] + l * 1024;
  const float* mods = (const float*)(p.ws + WS_MODS);
  bfu* xn = ws_bf(p, WS_XN);
  for (int row = blockIdx.x * 8 + w; row < NTOK; row += gridDim.x * 8) {
    const float* src;
    if (first) src = (row < NCTX) ? p.in[I_XP] + (size_t)row * 1024 : p.in[I_XS] + (size_t)(row - NCTX) * 1024;
    else src = p.out + (size_t)row * 1024;
    float4 v[4];
    float ss = 0.f;
#pragma unroll
    for (int i = 0; i < 4; i++) {
      v[i] = *(const float4*)(src + i * 256 + lane * 4);
      ss += v[i].x * v[i].x + v[i].y * v[i].y + v[i].z * v[i].z + v[i].w * v[i].w;
    }
    ss = wave_sum(ss);
    const float r = rsqrtf(ss * (1.f / 1024.f) + 1e-6f);
    const float* mb = mods + (size_t)(l * 9 + row_modidx(row)) * 9216;
    const float* sh = mb + (which * 3) * 1024;
    const float* scl = mb + (which * 3 + 1) * 1024;
#pragma unroll
    for (int i = 0; i < 4; i++) {
      int c = i * 256 + lane * 4;
      float4 gg = *(const float4*)(g + c), s4 = *(const float4*)(sh + c), c4 = *(const float4*)(scl + c);
      float o0 = v[i].x * r * gg.x * (1.f + c4.x) + s4.x;
      float o1 = v[i].y * r * gg.y * (1.f + c4.y) + s4.y;
      float o2 = v[i].z * r * gg.z * (1.f + c4.z) + s4.z;
      float o3 = v[i].w * r * gg.w * (1.f + c4.w) + s4.w;
      uint2 pk; pk.x = pack2(o0, o1); pk.y = pack2(o2, o3);
      *(uint2*)(xn + (size_t)row * 1024 + c) = pk;
    }
  }
}

__device__ __forceinline__ void phase_final_norm(const Params& p) {
  const int lane = tid_() & 63, w = tid_() >> 6;
  const float* g = p.in[I_FN];
  for (int row = blockIdx.x * 8 + w; row < NTOK; row += gridDim.x * 8) {
    float* src = p.out + (size_t)row * 1024;
    float4 v[4];
    float ss = 0.f;
#pragma unroll
    for (int i = 0; i < 4; i++) {
      v[i] = *(const float4*)(src + i * 256 + lane * 4);
      ss += v[i].x * v[i].x + v[i].y * v[i].y + v[i].z * v[i].z + v[i].w * v[i].w;
    }
    ss = wave_sum(ss);
    const float r = rsqrtf(ss * (1.f / 1024.f) + 1e-6f);
#pragma unroll
    for (int i = 0; i < 4; i++) {
      int c = i * 256 + lane * 4;
      float4 gg = *(const float4*)(g + c);
      float4 o;
      o.x = v[i].x * r * gg.x; o.y = v[i].y * r * gg.y; o.z = v[i].z * r * gg.z; o.w = v[i].w * r * gg.w;
      *(float4*)(src + c) = o;
    }
  }
}

typedef unsigned u32x4 __attribute__((ext_vector_type(4)));
template <int MI>
__device__ __forceinline__ void gemm_compute(const char* sb, int fa_off, int fb_off, int lq, int sw, f32x4 (&acc)[MI][4]) {
#pragma unroll
  for (int ks = 0; ks < 2; ks++) {
    const int ch = ((ks * 4 + lq) ^ sw) << 4;
    bf16x8 af[MI], bfr[4];
#pragma unroll
    for (int mi = 0; mi < MI; mi++) af[mi] = *(const bf16x8*)(sb + fa_off + mi * 16 * 128 + ch);
#pragma unroll
    for (int ni = 0; ni < 4; ni++) bfr[ni] = *(const bf16x8*)(sb + fb_off + ni * 16 * 128 + ch);
#pragma unroll
    for (int mi = 0; mi < MI; mi++)
#pragma unroll
      for (int ni = 0; ni < 4; ni++)
        acc[mi][ni] = __builtin_amdgcn_mfma_f32_16x16x32_bf16(bfr[ni], af[mi], acc[mi][ni], 0, 0, 0);
  }
}

template <int MI>
__device__ __forceinline__ void gemm_main(const bfu* __restrict__ A, int lda, const bfu* __restrict__ Bt, int ldb,
                                          int K, f32x4 (&acc)[MI][4], char* lds) {
  constexpr int BM = 64 * MI;
  constexpr int STAGE = (BM + 128) * 128;
  const int tid = tid_(), lane = tid & 63, w = tid >> 6, wm = w >> 1, wn = w & 1;
  const int lrow = tid >> 3, lch = tid & 7;
  const bfu* ap = A + (size_t)lrow * lda + lch * 8;
  const bfu* bp = Bt + (size_t)lrow * ldb + lch * 8;
  const int st_off = lrow * 128 + ((lch ^ ((lrow >> 1) & 7)) << 4);
  const int sw = (lane & 15) >> 1, lq = lane >> 4;
  const int fa_off = (wm * 16 * MI + (lane & 15)) * 128;
  const int fb_off = BM * 128 + (wn * 64 + (lane & 15)) * 128;
  u32x4 ra0[MI], rb0[2], ra1[MI], rb1[2];
  const int nk = K >> 6;
  __syncthreads();
  {
      const int ko_ = (0) << 6;
#pragma unroll
      for (int i = 0; i < MI; i++) ra0[i] = *(const u32x4*)(ap + (size_t)i * 64 * lda + ko_);
#pragma unroll
      for (int i = 0; i < 2; i++) rb0[i] = *(const u32x4*)(bp + (size_t)i * 64 * ldb + ko_);
    }
  {
      const int ko_ = (1) << 6;
#pragma unroll
      for (int i = 0; i < MI; i++) ra1[i] = *(const u32x4*)(ap + (size_t)i * 64 * lda + ko_);
#pragma unroll
      for (int i = 0; i < 2; i++) rb1[i] = *(const u32x4*)(bp + (size_t)i * 64 * ldb + ko_);
    }
  {
#pragma unroll
      for (int i = 0; i < MI; i++) *(u32x4*)(lds + st_off + i * 64 * 128) = ra0[i];
#pragma unroll
      for (int i = 0; i < 2; i++) *(u32x4*)(lds + BM * 128 + st_off + i * 64 * 128) = rb0[i];
    }
  __syncthreads();
#pragma unroll 1
  for (int kt = 0; kt < nk; kt += 2) {
    {
      const int ko_ = ((kt + 2 < nk) ? kt + 2 : kt) << 6;
#pragma unroll
      for (int i = 0; i < MI; i++) ra0[i] = *(const u32x4*)(ap + (size_t)i * 64 * lda + ko_);
#pragma unroll
      for (int i = 0; i < 2; i++) rb0[i] = *(const u32x4*)(bp + (size_t)i * 64 * ldb + ko_);
    }
    gemm_compute<MI>(lds, fa_off, fb_off, lq, sw, acc);
    {
#pragma unroll
      for (int i = 0; i < MI; i++) *(u32x4*)((lds + STAGE) + st_off + i * 64 * 128) = ra1[i];
#pragma unroll
      for (int i = 0; i < 2; i++) *(u32x4*)((lds + STAGE) + BM * 128 + st_off + i * 64 * 128) = rb1[i];
    }
    __syncthreads();
    {
      const int ko_ = ((kt + 3 < nk) ? kt + 3 : kt) << 6;
#pragma unroll
      for (int i = 0; i < MI; i++) ra1[i] = *(const u32x4*)(ap + (size_t)i * 64 * lda + ko_);
#pragma unroll
      for (int i = 0; i < 2; i++) rb1[i] = *(const u32x4*)(bp + (size_t)i * 64 * ldb + ko_);
    }
    gemm_compute<MI>(lds + STAGE, fa_off, fb_off, lq, sw, acc);
    if (kt + 2 < nk) {
#pragma unroll
      for (int i = 0; i < MI; i++) *(u32x4*)(lds + st_off + i * 64 * 128) = ra0[i];
#pragma unroll
      for (int i = 0; i < 2; i++) *(u32x4*)(lds + BM * 128 + st_off + i * 64 * 128) = rb0[i];
    }
    __syncthreads();
  }
}

__device__ __forceinline__ void gemm2_compute(const char* sb, int fa_off, int fb_off, int lq, int sw, f32x4 (&acc)[4][8]) {
#pragma unroll
  for (int ks = 0; ks < 2; ks++) {
    const int ch = ((ks * 4 + lq) ^ sw) << 4;
    bf16x8 af[4], bfr[8];
#pragma unroll
    for (int mi = 0; mi < 4; mi++) af[mi] = *(const bf16x8*)(sb + fa_off + mi * 16 * 128 + ch);
#pragma unroll
    for (int ni = 0; ni < 8; ni++) bfr[ni] = *(const bf16x8*)(sb + fb_off + ni * 16 * 128 + ch);
#pragma unroll
    for (int mi = 0; mi < 4; mi++)
#pragma unroll
      for (int ni = 0; ni < 8; ni++)
        acc[mi][ni] = __builtin_amdgcn_mfma_f32_16x16x32_bf16(bfr[ni], af[mi], acc[mi][ni], 0, 0, 0);
  }
}
__device__ __forceinline__ void gemm_main2(const bfu* __restrict__ A, int lda, const bfu* __restrict__ Bt, int ldb, int K,
                                           f32x4 (&acc)[4][8], char* lds) {
  constexpr int STAGE = 512 * 128;
  const int tid = tid_(), lane = tid & 63, w = tid >> 6, wm = w >> 1, wn = w & 1;
  const int lrow = tid >> 3, lch = tid & 7;
  const bfu* ap = A + (size_t)lrow * lda + lch * 8;
  const bfu* bp = Bt + (size_t)lrow * ldb + lch * 8;
  const int st_off = lrow * 128 + ((lch ^ ((lrow >> 1) & 7)) << 4);
  const int sw = (lane & 15) >> 1, lq = lane >> 4;
  const int fa_off = (wm * 64 + (lane & 15)) * 128;
  const int fb_off = 256 * 128 + (wn * 128 + (lane & 15)) * 128;
  u32x4 ra0[4], rb0[4], ra1[4], rb1[4];
  const int nk = K >> 6;
  __syncthreads();
#pragma unroll
  for (int i = 0; i < 4; i++) ra0[i] = *(const u32x4*)(ap + (size_t)i * 64 * lda);
#pragma unroll
  for (int i = 0; i < 4; i++) rb0[i] = *(const u32x4*)(bp + (size_t)i * 64 * ldb);
#pragma unroll
  for (int i = 0; i < 4; i++) ra1[i] = *(const u32x4*)(ap + (size_t)i * 64 * lda + 64);
#pragma unroll
  for (int i = 0; i < 4; i++) rb1[i] = *(const u32x4*)(bp + (size_t)i * 64 * ldb + 64);
#pragma unroll
  for (int i = 0; i < 4; i++) *(u32x4*)(lds + st_off + i * 64 * 128) = ra0[i];
#pragma unroll
  for (int i = 0; i < 4; i++) *(u32x4*)(lds + 256 * 128 + st_off + i * 64 * 128) = rb0[i];
  __syncthreads();
#pragma unroll 1
  for (int kt = 0; kt < nk; kt += 2) {
    {
      const int ko = ((kt + 2 < nk) ? kt + 2 : kt) << 6;
#pragma unroll
      for (int i = 0; i < 4; i++) ra0[i] = *(const u32x4*)(ap + (size_t)i * 64 * lda + ko);
#pragma unroll
      for (int i = 0; i < 4; i++) rb0[i] = *(const u32x4*)(bp + (size_t)i * 64 * ldb + ko);
    }
    gemm2_compute(lds, fa_off, fb_off, lq, sw, acc);
#pragma unroll
    for (int i = 0; i < 4; i++) *(u32x4*)(lds + STAGE + st_off + i * 64 * 128) = ra1[i];
#pragma unroll
    for (int i = 0; i < 4; i++) *(u32x4*)(lds + STAGE + 256 * 128 + st_off + i * 64 * 128) = rb1[i];
    __syncthreads();
    {
      const int ko = ((kt + 3 < nk) ? kt + 3 : kt) << 6;
#pragma unroll
      for (int i = 0; i < 4; i++) ra1[i] = *(const u32x4*)(ap + (size_t)i * 64 * lda + ko);
#pragma unroll
      for (int i = 0; i < 4; i++) rb1[i] = *(const u32x4*)(bp + (size_t)i * 64 * ldb + ko);
    }
    gemm2_compute(lds + STAGE, fa_off, fb_off, lq, sw, acc);
    if (kt + 2 < nk) {
#pragma unroll
      for (int i = 0; i < 4; i++) *(u32x4*)(lds + st_off + i * 64 * 128) = ra0[i];
#pragma unroll
      for (int i = 0; i < 4; i++) *(u32x4*)(lds + 256 * 128 + st_off + i * 64 * 128) = rb0[i];
    }
    __syncthreads();
  }
}

template <int MI>
__device__ __forceinline__ void zero_acc(f32x4 (&acc)[MI][4]) {
#pragma unroll
  for (int mi = 0; mi < MI; mi++)
#pragma unroll
    for (int ni = 0; ni < 4; ni++) acc[mi][ni] = f32x4{0.f, 0.f, 0.f, 0.f};
}

__device__ __forceinline__ void remap_tile(int t, int nM, int nN, int& tm, int& tn) {
  const int band = nM >> 3;
  if ((nM & 7) == 0 && band % 5 == 0) {
    const int x = t & 7, q = t >> 3;
    const int per = 5 * nN;
    const int sb = q / per, r = q % per;
    tm = x * band + sb * 5 + r % 5;
    tn = r / 5;
  } else {
    tm = t % nM;
    tn = t / nM;
  }
}

__device__ __forceinline__ void phase_gemm_w13(const Params& p, size_t wsoff, char* lds) {
  const bfu* A = ws_bf(p, WS_XN);
  const bfu* W = ws_bf(p, wsoff);
  bfu* act = ws_bf(p, WS_PROJ);
  const int lane = tid_() & 63, w = tid_() >> 6, wm = w >> 1, wn = w & 1;
  const int nM = NTOK / 256, nN = 5632 / 256;
  for (int t = blockIdx.x; t < nM * nN; t += gridDim.x) {
    int tm, tn;
    remap_tile(t, nM, nN, tm, tn);
    f32x4 acc[4][8];
#pragma unroll
    for (int mi = 0; mi < 4; mi++)
#pragma unroll
      for (int ni = 0; ni < 8; ni++) acc[mi][ni] = f32x4{0.f, 0.f, 0.f, 0.f};
    gemm_main2(A + (size_t)tm * 256 * 1024, 1024, W + (size_t)tn * 256 * 1024, 1024, 1024, acc, lds);
#pragma unroll
    for (int mi = 0; mi < 4; mi++)
#pragma unroll
      for (int np = 0; np < 4; np++) {
        const int row = tm * 256 + wm * 64 + mi * 16 + (lane & 15);
        const int col = tn * 128 + wn * 64 + np * 16 + (lane >> 4) * 4;
        float o[4];
#pragma unroll
        for (int j = 0; j < 4; j++) o[j] = siluf_(acc[mi][np * 2][j]) * acc[mi][np * 2 + 1][j];
        uint2 pk; pk.x = pack2(o[0], o[1]); pk.y = pack2(o[2], o[3]);
        *(uint2*)(act + (size_t)row * DFF + col) = pk;
      }
  }
}

template <int MI>
__device__ __forceinline__ void gemm_res_tile(const Params& p, int l, const bfu* A, int lda, int K, const bfu* W, int midx,
                                              float coef, bool first, int row0, int tn, char* lds, bool dry) {
  const float* mods = (const float*)(p.ws + WS_MODS);
  const int lane = tid_() & 63, w = tid_() >> 6, wm = w >> 1, wn = w & 1;
  f32x4 acc[MI][4];
  zero_acc<MI>(acc);
  gemm_main<MI>(A + (size_t)row0 * lda, lda, W + (size_t)tn * 128 * K, K, K, acc, lds);
#pragma unroll
  for (int mi = 0; mi < MI; mi++) {
    const int row = row0 + wm * 16 * MI + mi * 16 + (lane & 15);
    const float* mrow = mods + (size_t)(l * 9 + row_modidx(row)) * 9216 + midx * 1024;
    const float* res;
    if (first) res = (row < NCTX) ? p.in[I_XP] + (size_t)row * 1024 : p.in[I_XS] + (size_t)(row - NCTX) * 1024;
    else res = p.out + (size_t)row * 1024;
    float* dst = p.out + (size_t)row * 1024;
#pragma unroll
    for (int ni = 0; ni < 4; ni++) {
      const int col = tn * 128 + wn * 64 + ni * 16 + (lane >> 4) * 4;
      const float4 r4 = *(const float4*)(res + col), m4 = *(const float4*)(mrow + col);
      float4 o;
      o.x = r4.x + coef * m4.x * acc[mi][ni][0];
      o.y = r4.y + coef * m4.y * acc[mi][ni][1];
      o.z = r4.z + coef * m4.z * acc[mi][ni][2];
      o.w = r4.w + coef * m4.w * acc[mi][ni][3];
      if (!dry || o.x == 123456.789f) *(float4*)(dst + col) = o;
    }
  }
}

__device__ __forceinline__ void phase_gemm_res(const Params& p, int l, const bfu* A, int lda, int K, size_t wsoff, int midx,
                                               float coef, bool first, char* lds, bool dry = false) {
  const bfu* W = ws_bf(p, wsoff);
  const int nM = NTOK / 256, ntiles = nM * 8;
  const int nfull = (ntiles / (int)gridDim.x) * (int)gridDim.x;
  for (int t = blockIdx.x; t < nfull; t += gridDim.x)
  {
    int tm, tn;
    remap_tile(t, nM, 8, tm, tn);
    gemm_res_tile<4>(p, l, A, lda, K, W, midx, coef, first, tm * 256, tn, lds, dry);
  }
  for (int s = blockIdx.x; s < (ntiles - nfull) * 2; s += gridDim.x) {
    const int big = nfull + (s >> 1);
    int tm, tn;
    remap_tile(big, nM, 8, tm, tn);
    gemm_res_tile<2>(p, l, A, lda, K, W, midx, coef, first, tm * 256 + (s & 1) * 128, tn, lds, dry);
  }
}

__device__ __forceinline__ void phase_gemm_win(const Params& p, char* lds) {
  const bfu* A = ws_bf(p, WS_XN);
  const bfu* W = ws_bf(p, WS_WIN);
  bfu* proj = ws_bf(p, WS_PROJ);
  float* ctrl = (float*)(p.ws + WS_CTRL);
  const int lane = tid_() & 63, w = tid_() >> 6, wm = w >> 1, wn = w & 1;
  const int nM = NTOK / 256, nN = LDP / 256;
  for (int t = blockIdx.x; t < nM * nN; t += gridDim.x) {
    int tm, tn;
    remap_tile(t, nM, nN, tm, tn);
    f32x4 acc[4][8];
#pragma unroll
    for (int mi = 0; mi < 4; mi++)
#pragma unroll
      for (int ni = 0; ni < 8; ni++) acc[mi][ni] = f32x4{0.f, 0.f, 0.f, 0.f};
    gemm_main2(A + (size_t)tm * 256 * 1024, 1024, W + (size_t)tn * 256 * 1024, 1024, 1024, acc, lds);
#pragma unroll
    for (int ni = 0; ni < 8; ni++) {
      const int cb = tn * 256 + wn * 128 + ni * 16;
      const int col = cb + (lane >> 4) * 4;
      int cc = -1;
      if (cb == C_DT) cc = (lane >> 4) * 4;
      else if (cb == C_BETA) cc = 16 + (lane >> 4) * 4;
      else if (cb == C_AC) cc = 32 + (lane >> 4) * 4;
#pragma unroll
      for (int mi = 0; mi < 4; mi++) {
        const int row = tm * 256 + wm * 64 + mi * 16 + (lane & 15);
        uint2 pk; pk.x = pack2(acc[mi][ni][0], acc[mi][ni][1]); pk.y = pack2(acc[mi][ni][2], acc[mi][ni][3]);
        *(uint2*)(proj + (size_t)row * LDP + col) = pk;
        if (cc >= 0) *(float4*)(ctrl + (size_t)row * 48 + cc) = make_float4(acc[mi][ni][0], acc[mi][ni][1], acc[mi][ni][2], acc[mi][ni][3]);
      }
    }
  }
}

__device__ __forceinline__ void phase_gemm_merge(const Params& p, char* lds) {
  const bfu* XN = ws_bf(p, WS_XN);
  const bfu* WG = ws_bf(p, WS_WG);
  const bfu* WB = ws_bf(p, WS_WBR);
  bfu* proj = ws_bf(p, WS_PROJ);
  const int lane = tid_() & 63, w = tid_() >> 6, wm = w >> 1, wn = w & 1;
  const int nM = NTOK / 128, nN = 8;
  for (int t = blockIdx.x; t < nM * nN; t += gridDim.x) {
    int tm, tn;
    remap_tile(t, nM, nN, tm, tn);
    f32x4 mrg[2][4];
    zero_acc<2>(mrg);
#pragma unroll 1
    for (int n = 0; n < 4; n++) {
      f32x4 g[2][4], a[2][4];
      zero_acc<2>(g);
      gemm_main<2>(XN + (size_t)tm * 128 * 1024, 1024, WG + (size_t)(n * 1024 + tn * 128) * 1024, 1024, 1024, g, lds);
      zero_acc<2>(a);
      gemm_main<2>(proj + (size_t)tm * 128 * LDP + (n == 0 ? C_Z : n == 1 ? C_QB : n == 2 ? C_GC : C_YD), LDP, WB + (size_t)(n * 1024 + tn * 128) * 512, 512, 512, a, lds);
#pragma unroll
      for (int mi = 0; mi < 2; mi++)
#pragma unroll
        for (int ni = 0; ni < 4; ni++)
#pragma unroll
          for (int j = 0; j < 4; j++) mrg[mi][ni][j] += sigmoidf_(g[mi][ni][j]) * a[mi][ni][j];
    }
#pragma unroll
    for (int mi = 0; mi < 2; mi++)
#pragma unroll
      for (int ni = 0; ni < 4; ni++) {
        const int row = tm * 128 + wm * 32 + mi * 16 + (lane & 15);
        const int col = tn * 128 + wn * 64 + ni * 16 + (lane >> 4) * 4;
        uint2 pk; pk.x = pack2(mrg[mi][ni][0], mrg[mi][ni][1]); pk.y = pack2(mrg[mi][ni][2], mrg[mi][ni][3]);
        *(uint2*)(proj + (size_t)row * LDP + C_MRG + col) = pk;
      }
  }
}

__device__ __forceinline__ void phase_prep(const Params& p, int l) {
  const int lane = tid_() & 63, w = tid_() >> 6;
  bfu* proj = ws_bf(p, WS_PROJ);
  const float gq = p.in[I_QN][l * 64 + lane], gk = p.in[I_KN][l * 64 + lane];
  const float* rc = (const float*)(p.ws + WS_ROPE);
  const float* rs = rc + 1024;
  for (int row = blockIdx.x * 8 + w; row < NTOK; row += gridDim.x * 8) {
    const bool lat = row >= NCTX;
    const int t = lat ? ((row - NCTX) & 2047) : (row & 255);
    float cs = 1.f, sn = 0.f;
    if (lat) {
      int pos = (lane < 32) ? (t >> 6) : (t & 63);
      cs = rc[pos * 16 + (lane & 15)];
      sn = rs[pos * 16 + (lane & 15)];
    }
    const bool hi = (lane >> 4) & 1;
    for (int hv = 0; hv < 10; hv++) {
      bfu* ptr = proj + (size_t)row * LDP + (hv < 8 ? C_QB + hv * 64 : C_KB + (hv - 8) * 64) + lane;
      float x = bf2f(*ptr);
      float ss = wave_sum(x * x);
      float y = x * rsqrtf(ss * (1.f / 64.f) + 1e-6f) * (hv < 8 ? gq : gk);
      float o = y;
      if (lat) {
        float pr = __shfl_xor(y, 16, 64);
        o = hi ? (pr * sn + y * cs) : (y * cs - pr * sn);
      }
      *ptr = f2bf(o);
      if (!lat && hv >= 8) {
        int b = row >> 8;
        size_t idx = ((((size_t)b * 2 + l) * 256 + t) * 2 + (hv - 8)) * 64 + lane;
        p.out[O_NK + idx] = y;
        p.out[O_NV + idx] = bf2f(proj[(size_t)row * LDP + C_VB + (hv - 8) * 64 + lane]);
      }
    }
  }
}

__device__ __forceinline__ void conv8(const bfu* proj, int row0, int T, int tt, int col, const float* cw, int cwld,
                                      int cidx, const float* cb, float* o) {
  float4 b0 = *(const float4*)(cb + cidx), b1 = *(const float4*)(cb + cidx + 4);
  o[0] = b0.x; o[1] = b0.y; o[2] = b0.z; o[3] = b0.w; o[4] = b1.x; o[5] = b1.y; o[6] = b1.z; o[7] = b1.w;
#pragma unroll
  for (int j = 0; j < 4; j++) {
    int t2 = tt + j - 2;
    if (t2 >= 0 && t2 < T) {
      uint4 xv = *(const uint4*)(proj + (size_t)(row0 + t2) * LDP + col);
      float x[8];
      unpack8(xv, x);
      float4 w0 = *(const float4*)(cw + j * cwld + cidx), w1 = *(const float4*)(cw + j * cwld + cidx + 4);
      o[0] += w0.x * x[0]; o[1] += w0.y * x[1]; o[2] += w0.z * x[2]; o[3] += w0.w * x[3];
      o[4] += w1.x * x[4]; o[5] += w1.y * x[5]; o[6] += w1.z * x[6]; o[7] += w1.w * x[7];
    }
  }
}

__device__ __forceinline__ void scan_out(const float* ol, bfu* bufy, int row0, int ts, int dir, int t8, int colbase,
                                         bool second, const uint4& prev) {
  const int s = t8 >> 3, dc = t8 & 7;
  const int tt = dir ? ts + 31 - s : ts + s;
  float f[8];
  float4 a = *(const float4*)(ol + s * 64 + dc * 8), b = *(const float4*)(ol + s * 64 + dc * 8 + 4);
  f[0] = a.x; f[1] = a.y; f[2] = a.z; f[3] = a.w; f[4] = b.x; f[5] = b.y; f[6] = b.z; f[7] = b.w;
  bfu* dst = bufy + (size_t)(row0 + tt) * 512 + colbase + dc * 8;
  if (second) {
    float e[8];
    unpack8(prev, e);
#pragma unroll
    for (int i = 0; i < 8; i++) f[i] += e[i];
  }
  *(uint4*)dst = pack8(f);
}
__device__ __forceinline__ uint4 scan_prev(const bfu* bufy, int row0, int ts, int dir, int t8, int colbase, bool second) {
  const int s = t8 >> 3, dc = t8 & 7;
  const int tt = dir ? ts + 31 - s : ts + s;
  return second ? *(const uint4*)(bufy + (size_t)(row0 + tt) * 512 + colbase + dc * 8) : make_uint4(0, 0, 0, 0);
}

typedef float f32x2 __attribute__((ext_vector_type(2)));
__device__ __forceinline__ float quad_sum(float v) {
  v += __int_as_float(__builtin_amdgcn_update_dpp(0, __float_as_int(v), 0xB1, 0xF, 0xF, true));
  v += __int_as_float(__builtin_amdgcn_update_dpp(0, __float_as_int(v), 0x4E, 0xF, 0xF, true));
  return v;
}
__device__ __forceinline__ float oct_sum(float v) {
  v = quad_sum(v);
  v = DPP_ADD(v, 0x141);
  return v;
}
__device__ __forceinline__ void load_taps(const bfu* proj, int row0, int T, int tt, int col, uint4 (&raw)[4]) {
#pragma unroll
  for (int j = 0; j < 4; j++) {
    int t2 = tt + j - 2;
    raw[j] = (t2 >= 0 && t2 < T) ? *(const uint4*)(proj + (size_t)(row0 + t2) * LDP + col) : make_uint4(0, 0, 0, 0);
  }
}
__device__ __forceinline__ void conv_lds(const uint4 (&raw)[4], const float* cwl, int dc, float* o) {
  {
    float4 b0 = *(const float4*)(cwl + 4 * 64 + dc * 8), b1 = *(const float4*)(cwl + 4 * 64 + dc * 8 + 4);
    o[0] = b0.x; o[1] = b0.y; o[2] = b0.z; o[3] = b0.w; o[4] = b1.x; o[5] = b1.y; o[6] = b1.z; o[7] = b1.w;
  }
#pragma unroll
  for (int j = 0; j < 4; j++) {
    float x[8];
    unpack8(raw[j], x);
    float4 w0 = *(const float4*)(cwl + j * 64 + dc * 8), w1 = *(const float4*)(cwl + j * 64 + dc * 8 + 4);
    o[0] += w0.x * x[0]; o[1] += w0.y * x[1]; o[2] += w0.z * x[2]; o[3] += w0.w * x[3];
    o[4] += w1.x * x[4]; o[5] += w1.y * x[5]; o[6] += w1.z * x[6]; o[7] += w1.w * x[7];
  }
}
__device__ __forceinline__ void ld16(const float* src, f32x2 (&d)[8]) {
#pragma unroll
  for (int i = 0; i < 4; i++) {
    float4 a = *(const float4*)(src + i * 4);
    d[2 * i] = f32x2{a.x, a.y};
    d[2 * i + 1] = f32x2{a.z, a.w};
  }
}

typedef __attribute__((ext_vector_type(16))) float f32x16;
#define MFMA32(a, b, c) __builtin_amdgcn_mfma_f32_32x32x16_bf16((a), (b), (c), 0, 0, 0)
__device__ __forceinline__ int crow32(int r, int hi) { return (r & 3) + 8 * (r >> 2) + 4 * hi; }
__device__ __forceinline__ void st16bf(bfu* dst, const f32x2 (&S)[8]) {
  float f[16];
#pragma unroll
  for (int i = 0; i < 8; i++) { f[2 * i] = S[i].x; f[2 * i + 1] = S[i].y; }
  *(uint4*)dst = pack8(f);
  *(uint4*)(dst + 8) = pack8(f + 8);
}
__device__ __forceinline__ float prefix32(float x, int lane) {
#pragma unroll
  for (int off = 1; off < 32; off <<= 1) {
    float t = __shfl_up(x, off, 64);
    if (lane >= off) x += t;
  }
  return x;
}

__device__ __forceinline__ void delta_unit(const Params& p, int l, int seq, int h, char* lds) {
  const int tid = tid_(), dir = tid >> 8, t8 = tid & 255;
  const bool lat = seq >= 16;
  const int b = lat ? seq - 16 : seq, T = lat ? 2048 : 256, row0 = lat ? NCTX + b * 2048 : b * 256;
  char* dbase = lds + dir * 59776;
  float* vl = (float*)dbase;
  float* Ml = (float*)(dbase + 8192);
  bfu* kdT = (bfu*)(dbase + 12800);
  float* ol = (float*)(dbase + 17920);
  bfu* qb = (bfu*)(dbase + 26112), *kb = (bfu*)(dbase + 30720), *s0t = (bfu*)(dbase + 35328), *vnt = (bfu*)(dbase + 44544),
      *qkb = (bfu*)(dbase + 49664);
  float* bl = (float*)(dbase + 52224), *egc = bl + 32, *gcm = bl + 64, *wl = bl + 96;
  float* cwl = (float*)(dbase + 52736);
  const bfu* proj = ws_bf(p, WS_PROJ);
  const float* ctrl = (const float*)(p.ws + WS_CTRL);
  bfu* bufy = ws_bf(p, WS_BUFY) + (size_t)1 * NTOK * 512;
  const int s_ld = t8 >> 3, dc = t8 & 7;
  const int wv = t8 >> 6, lane = t8 & 63, m32 = lane & 31, hi = lane >> 5;
  const int kt = wv >> 1, vt = wv & 1;
  __syncthreads();
  {
    const float* cw = p.in[I_DCW] + (size_t)l * 4 * 1536;
    const float* cb = p.in[I_DCB] + (size_t)l * 1536;
    for (int i = t8; i < 960; i += 256) {
      int m = i / 320, j = (i % 320) >> 6, d = i & 63;
      cwl[i] = (j < 4) ? cw[j * 1536 + m * 512 + h * 64 + d] : cb[m * 512 + h * 64 + d];
    }
  }
  f32x16 Sacc;
  if (lat) {
    const float* s0 = p.in[I_SDELTA] + ((((size_t)b * 2 + l) * 2 + dir) * 8 + h) * 4096;
#pragma unroll
    for (int r = 0; r < 16; r++) Sacc[r] = s0[(kt * 32 + crow32(r, hi)) * 64 + vt * 32 + m32];
  } else {
#pragma unroll
    for (int r = 0; r < 16; r++) Sacc[r] = 0.f;
  }
  const float neg_a = -__expf(p.in[I_DALOG][(l * 2 + dir) * 8 + h]);
  const float dtb = p.in[I_DDTB][(l * 2 + dir) * 8 + h];
  const int nc = T >> 5;
  uint4 raw[3][4];
  float c_a = 0.f, c_b = 0.f;
  {
    const int ts = (dir ? nc - 1 : 0) << 5;
    const int tt = dir ? ts + 31 - s_ld : ts + s_ld;
#pragma unroll
    for (int m = 0; m < 3; m++) load_taps(proj, row0, T, tt, C_QC + m * 512 + h * 64 + dc * 8, raw[m]);
    if (t8 < 32) {
      const int tt2 = dir ? ts + 31 - t8 : ts + t8;
      const float* cr = ctrl + (size_t)(row0 + tt2) * 48;
      c_a = cr[32 + dir * 8 + h]; c_b = cr[16 + dir * 8 + h];
    }
  }
  __syncthreads();
  for (int c = 0; c < nc; c++) {
    const int ts = (dir ? nc - 1 - c : c) << 5;
    const uint4 yprev = scan_prev(bufy, row0, ts, dir, t8, h * 64, c >= (nc >> 1));
#pragma unroll
    for (int g4 = 0; g4 < 4; g4++) {
      uint2 pk;
      pk.x = pack2(Sacc[4 * g4], Sacc[4 * g4 + 1]);
      pk.y = pack2(Sacc[4 * g4 + 2], Sacc[4 * g4 + 3]);
      *(uint2*)(s0t + (vt * 32 + m32) * 72 + kt * 32 + 8 * g4 + 4 * hi) = pk;
    }
    if (t8 < 32) {
      const float g = neg_a * softplusf_(c_a + dtb);
      const float gc = prefix32(g, t8);
      const float gc_end = __shfl(gc, 31, 64);
      bl[t8] = sigmoidf_(c_b);
      gcm[t8] = gc;
      egc[t8] = __expf(gc);
      wl[t8] = __expf(gc_end - gc);
    }
    __syncthreads();
    {
      const float wsc = wl[s_ld];
      float oq[8], ok[8], ov[8];
      conv_lds(raw[0], cwl, dc, oq);
      conv_lds(raw[1], cwl + 320, dc, ok);
      conv_lds(raw[2], cwl + 640, dc, ov);
      float sq = 0.f, sk = 0.f;
#pragma unroll
      for (int i = 0; i < 8; i++) {
        oq[i] = siluf_(oq[i]); ok[i] = siluf_(ok[i]); ov[i] = siluf_(ov[i]);
        sq += oq[i] * oq[i]; sk += ok[i] * ok[i];
      }
      sq = oct_sum(sq); sk = oct_sum(sk);
      const float rq = rsqrtf(sq + 1e-6f) * 0.125f, rk = rsqrtf(sk + 1e-6f);
#pragma unroll
      for (int i = 0; i < 8; i++) { oq[i] *= rq; ok[i] *= rk; }
      *(uint4*)(qb + s_ld * 72 + dc * 8) = pack8(oq);
      *(uint4*)(kb + s_ld * 72 + dc * 8) = pack8(ok);
#pragma unroll
      for (int i = 0; i < 8; i += 2) {
        const unsigned pw = pack2(ok[i] * wsc, ok[i + 1] * wsc);
        kdT[(dc * 8 + i) * 40 + s_ld] = (bfu)(pw & 0xffff);
        kdT[(dc * 8 + i + 1) * 40 + s_ld] = (bfu)(pw >> 16);
      }
      *(float4*)(vl + s_ld * 64 + dc * 8) = make_float4(ov[0], ov[1], ov[2], ov[3]);
      *(float4*)(vl + s_ld * 64 + dc * 8 + 4) = make_float4(ov[4], ov[5], ov[6], ov[7]);
    }
    __syncthreads();
    {
      f32x16 acc;
#pragma unroll
      for (int r = 0; r < 16; r++) acc[r] = 0.f;
      const bfu* bsrc = (wv < 2) ? (s0t + (wv * 32 + m32) * 72) : (kb + m32 * 72);
      const bfu* asrc = (wv == 3) ? (qb + m32 * 72) : (kb + m32 * 72);
#pragma unroll
      for (int kk = 0; kk < 4; kk++) {
        const bf16x8 a = *(const bf16x8*)(asrc + kk * 16 + hi * 8);
        const bf16x8 bb = *(const bf16x8*)(bsrc + kk * 16 + hi * 8);
        acc = MFMA32(a, bb, acc);
      }
      if (wv < 2) {
#pragma unroll
        for (int r = 0; r < 16; r++) {
          const int s = crow32(r, hi);
          float* pv = vl + s * 64 + wv * 32 + m32;
          *pv = bl[s] * (*pv - egc[s] * acc[r]);
        }
      } else {
        const float gj = gcm[m32];
#pragma unroll
        for (int r = 0; r < 16; r++) {
          const int i = crow32(r, hi);
          const float dec = __expf(gcm[i] - gj);
          if (wv == 2) Ml[i * 36 + m32] = (m32 < i) ? bl[i] * acc[r] * dec : 0.f;
          else qkb[i * 40 + m32] = f2bf((m32 <= i) ? acc[r] * dec : 0.f);
        }
      }
    }
    __syncthreads();
    if (wv == dir) {
      float x[16];
#pragma unroll
      for (int i = 0; i < 16; i++) {
        float a = vl[i * 64 + lane];
#pragma unroll
        for (int j = 0; j < i; j++) a -= Ml[i * 36 + j] * x[j];
        x[i] = a;
      }
#pragma unroll
      for (int i = 0; i < 16; i += 2) *(unsigned*)(vnt + lane * 40 + i) = pack2(x[i], x[i + 1]);
#pragma unroll 1
      for (int i = 16; i < 32; i++) {
        float a = vl[i * 64 + lane];
        const float* mr = Ml + i * 36;
#pragma unroll
        for (int j = 0; j < 16; j++) a -= mr[j] * x[j];
        vl[i * 64 + lane] = a;
      }
#pragma unroll
      for (int i = 0; i < 16; i++) {
        float a = vl[(16 + i) * 64 + lane];
#pragma unroll
        for (int j = 0; j < i; j++) a -= Ml[(16 + i) * 36 + 16 + j] * x[j];
        x[i] = a;
      }
#pragma unroll
      for (int i = 0; i < 16; i += 2) *(unsigned*)(vnt + lane * 40 + 16 + i) = pack2(x[i], x[i + 1]);
    }
    __syncthreads();
    if (c + 1 < nc) {
      const int ts2 = (dir ? nc - 2 - c : c + 1) << 5;
      const int tt = dir ? ts2 + 31 - s_ld : ts2 + s_ld;
#pragma unroll
      for (int m = 0; m < 3; m++) load_taps(proj, row0, T, tt, C_QC + m * 512 + h * 64 + dc * 8, raw[m]);
      if (t8 < 32) {
        const int tt2 = dir ? ts2 + 31 - t8 : ts2 + t8;
        const float* cr = ctrl + (size_t)(row0 + tt2) * 48;
        c_a = cr[32 + dir * 8 + h]; c_b = cr[16 + dir * 8 + h];
      }
    }
    {
      const float dtot = egc[31];
#pragma unroll
      for (int r = 0; r < 16; r++) Sacc[r] *= dtot;
#pragma unroll
      for (int jj = 0; jj < 2; jj++) {
        const bf16x8 a = *(const bf16x8*)(kdT + (kt * 32 + m32) * 40 + jj * 16 + hi * 8);
        const bf16x8 bb = *(const bf16x8*)(vnt + (vt * 32 + m32) * 40 + jj * 16 + hi * 8);
        Sacc = MFMA32(a, bb, Sacc);
      }
    }
    if (wv < 2) {
      const int v0 = wv * 32;
      f32x16 acc;
#pragma unroll
      for (int r = 0; r < 16; r++) acc[r] = 0.f;
#pragma unroll
      for (int kk = 0; kk < 4; kk++) {
        const bf16x8 a = *(const bf16x8*)(qb + m32 * 72 + kk * 16 + hi * 8);
        const bf16x8 bb = *(const bf16x8*)(s0t + (v0 + m32) * 72 + kk * 16 + hi * 8);
        acc = MFMA32(a, bb, acc);
      }
#pragma unroll
      for (int r = 0; r < 16; r++) acc[r] *= egc[crow32(r, hi)];
#pragma unroll
      for (int jj = 0; jj < 2; jj++) {
        const bf16x8 a = *(const bf16x8*)(qkb + m32 * 40 + jj * 16 + hi * 8);
        const bf16x8 bb = *(const bf16x8*)(vnt + (v0 + m32) * 40 + jj * 16 + hi * 8);
        acc = MFMA32(a, bb, acc);
      }
#pragma unroll
      for (int r = 0; r < 16; r++) ol[crow32(r, hi) * 64 + v0 + m32] = acc[r];
    }
    __syncthreads();
    scan_out(ol, bufy, row0, ts, dir, t8, h * 64, c >= (nc >> 1), yprev);
    if (c == (nc >> 1) - 1) { __threadfence(); __syncthreads(); }
  }
  if (!lat) {
    float* dst = p.out + O_DELTA + ((((size_t)b * 2 + l) * 2 + dir) * 8 + h) * 4096;
#pragma unroll
    for (int r = 0; r < 16; r++) dst[(kt * 32 + crow32(r, hi)) * 64 + vt * 32 + m32] = Sacc[r];
  }
}

__device__ __forceinline__ void ssd_unit(const Params& p, int l, int seq, int h, char* lds) {
  const int tid = tid_(), dir = tid >> 8, t8 = tid & 255;
  const bool lat = seq >= 16;
  const int b = lat ? seq - 16 : seq, T = lat ? 2048 : 256, row0 = lat ? NCTX + b * 2048 : b * 256;
  char* dbase = lds + dir * 59776;
  float* xl = (float*)dbase;
  bfu* xwT = (bfu*)(dbase + 8192), *bT = (bfu*)(dbase + 13312);
  float* ol = (float*)(dbase + 18432);
  bfu* cbf = (bfu*)(dbase + 26624), *bbf = (bfu*)(dbase + 31232), *h0b = (bfu*)(dbase + 35840), *xT = (bfu*)(dbase + 45056),
      *scb = (bfu*)(dbase + 50176);
  float* dtl = (float*)(dbase + 55296), *eal = dtl + 32, *acl = dtl + 64, *wl = dtl + 96;
  float* cwl = (float*)(dbase + 55936);
  const bfu* proj = ws_bf(p, WS_PROJ);
  const float* ctrl = (const float*)(p.ws + WS_CTRL);
  bfu* bufy = ws_bf(p, WS_BUFY);
  const int s_ld = t8 >> 3, dc = t8 & 7;
  const int wv = t8 >> 6, lane = t8 & 63, m32 = lane & 31, hi = lane >> 5;
  const int pt = wv >> 1, nt = wv & 1;
  const int grp = h >> 2;
  __syncthreads();
  {
    const float* cw = p.in[I_SCW] + (size_t)l * 4 * 768;
    const float* cb = p.in[I_SCB] + (size_t)l * 768;
    for (int i = t8; i < 960; i += 256) {
      int m = i / 320, j = (i % 320) >> 6, d = i & 63;
      int cidx = (m == 0) ? h * 64 + d : (m == 1 ? 512 + grp * 64 + d : 640 + grp * 64 + d);
      cwl[i] = (j < 4) ? cw[j * 768 + cidx] : cb[cidx];
    }
  }
  f32x16 Hacc;
  if (lat) {
    const float* s0 = p.in[I_SSSM] + ((((size_t)b * 2 + l) * 2 + dir) * 8 + h) * 4096;
#pragma unroll
    for (int r = 0; r < 16; r++) Hacc[r] = s0[(pt * 32 + crow32(r, hi)) * 64 + nt * 32 + m32];
  } else {
#pragma unroll
    for (int r = 0; r < 16; r++) Hacc[r] = 0.f;
  }
  const float a_ssm = -__expf(p.in[I_SALOG][(l * 2 + dir) * 8 + h]);
  const float dtb = p.in[I_SDTB][(l * 2 + dir) * 8 + h];
  const float Dh = (dir == 0) ? p.in[I_SD][l * 8 + h] : 0.f;
  const int nc = T >> 5;
  const int col0 = C_XBC + h * 64 + dc * 8, col1 = C_XBC + 512 + grp * 64 + dc * 8, col2 = C_XBC + 640 + grp * 64 + dc * 8;
  uint4 raw[3][4];
  float c_dt = 0.f;
  {
    const int ts = (dir ? nc - 1 : 0) << 5;
    const int tt = dir ? ts + 31 - s_ld : ts + s_ld;
    load_taps(proj, row0, T, tt, col0, raw[0]);
    load_taps(proj, row0, T, tt, col1, raw[1]);
    load_taps(proj, row0, T, tt, col2, raw[2]);
    if (t8 < 32) {
      const int tt2 = dir ? ts + 31 - t8 : ts + t8;
      c_dt = ctrl[(size_t)(row0 + tt2) * 48 + dir * 8 + h];
    }
  }
  __syncthreads();
  for (int c = 0; c < nc; c++) {
    const int ts = (dir ? nc - 1 - c : c) << 5;
    const uint4 yprev = scan_prev(bufy, row0, ts, dir, t8, h * 64, c >= (nc >> 1));
#pragma unroll
    for (int r = 0; r < 16; r++) h0b[(pt * 32 + crow32(r, hi)) * 72 + nt * 32 + m32] = f2bf(Hacc[r]);
    if (t8 < 32) {
      const float dt = softplusf_(c_dt + dtb);
      const float la = dt * a_ssm;
      const float ac = prefix32(la, t8);
      const float ac_end = __shfl(ac, 31, 64);
      dtl[t8] = dt;
      acl[t8] = ac;
      eal[t8] = __expf(ac);
      wl[t8] = __expf(ac_end - ac) * dt;
    }
    __syncthreads();
    {
      const float wsc = wl[s_ld];
      float o[8];
      conv_lds(raw[0], cwl, dc, o);
#pragma unroll
      for (int i = 0; i < 8; i++) o[i] = siluf_(o[i]);
      *(float4*)(xl + s_ld * 64 + dc * 8) = make_float4(o[0], o[1], o[2], o[3]);
      *(float4*)(xl + s_ld * 64 + dc * 8 + 4) = make_float4(o[4], o[5], o[6], o[7]);
#pragma unroll
      for (int i = 0; i < 8; i += 2) {
        const unsigned pk = pack2(o[i], o[i + 1]), pw = pack2(o[i] * wsc, o[i + 1] * wsc);
        xT[(dc * 8 + i) * 40 + s_ld] = (bfu)(pk & 0xffff);
        xT[(dc * 8 + i + 1) * 40 + s_ld] = (bfu)(pk >> 16);
        xwT[(dc * 8 + i) * 40 + s_ld] = (bfu)(pw & 0xffff);
        xwT[(dc * 8 + i + 1) * 40 + s_ld] = (bfu)(pw >> 16);
      }
      conv_lds(raw[1], cwl + 320, dc, o);
#pragma unroll
      for (int i = 0; i < 8; i++) o[i] = siluf_(o[i]);
      {
        const uint4 pb = pack8(o);
        *(uint4*)(bbf + s_ld * 72 + dc * 8) = pb;
        bT[(dc * 8 + 0) * 40 + s_ld] = (bfu)(pb.x & 0xffff); bT[(dc * 8 + 1) * 40 + s_ld] = (bfu)(pb.x >> 16);
        bT[(dc * 8 + 2) * 40 + s_ld] = (bfu)(pb.y & 0xffff); bT[(dc * 8 + 3) * 40 + s_ld] = (bfu)(pb.y >> 16);
        bT[(dc * 8 + 4) * 40 + s_ld] = (bfu)(pb.z & 0xffff); bT[(dc * 8 + 5) * 40 + s_ld] = (bfu)(pb.z >> 16);
        bT[(dc * 8 + 6) * 40 + s_ld] = (bfu)(pb.w & 0xffff); bT[(dc * 8 + 7) * 40 + s_ld] = (bfu)(pb.w >> 16);
      }
      conv_lds(raw[2], cwl + 640, dc, o);
#pragma unroll
      for (int i = 0; i < 8; i++) o[i] = siluf_(o[i]);
      *(uint4*)(cbf + s_ld * 72 + dc * 8) = pack8(o);
    }
    __syncthreads();
    if (c + 1 < nc) {
      const int ts2 = (dir ? nc - 2 - c : c + 1) << 5;
      const int tt = dir ? ts2 + 31 - s_ld : ts2 + s_ld;
      load_taps(proj, row0, T, tt, col0, raw[0]);
      load_taps(proj, row0, T, tt, col1, raw[1]);
      load_taps(proj, row0, T, tt, col2, raw[2]);
      if (t8 < 32) {
        const int tt2 = dir ? ts2 + 31 - t8 : ts2 + t8;
        c_dt = ctrl[(size_t)(row0 + tt2) * 48 + dir * 8 + h];
      }
    }
    {
      const float dtot = eal[31];
#pragma unroll
      for (int r = 0; r < 16; r++) Hacc[r] *= dtot;
#pragma unroll
      for (int jj = 0; jj < 2; jj++) {
        const bf16x8 a = *(const bf16x8*)(xwT + (pt * 32 + m32) * 40 + jj * 16 + hi * 8);
        const bf16x8 bb = *(const bf16x8*)(bT + (nt * 32 + m32) * 40 + jj * 16 + hi * 8);
        Hacc = MFMA32(a, bb, Hacc);
      }
    }
    bfu* mysc = scb + (wv & 1) * 1280;
    if (wv < 2) {
      f32x16 acc;
#pragma unroll
      for (int r = 0; r < 16; r++) acc[r] = 0.f;
#pragma unroll
      for (int kk = 0; kk < 4; kk++) {
        const bf16x8 a = *(const bf16x8*)(cbf + m32 * 72 + kk * 16 + hi * 8);
        const bf16x8 bb = *(const bf16x8*)(bbf + m32 * 72 + kk * 16 + hi * 8);
        acc = MFMA32(a, bb, acc);
      }
      const float aj = acl[m32], dj = dtl[m32];
#pragma unroll
      for (int r = 0; r < 16; r++) {
        const int i = crow32(r, hi);
        const float val = (m32 <= i) ? acc[r] * __expf(acl[i] - aj) * dj : 0.f;
        mysc[i * 40 + m32] = f2bf(val);
      }
    }
    __syncthreads();
    if (wv < 2) {
      const int p0 = wv * 32;
      f32x16 acc;
#pragma unroll
      for (int r = 0; r < 16; r++) acc[r] = 0.f;
#pragma unroll
      for (int kk = 0; kk < 4; kk++) {
        const bf16x8 a = *(const bf16x8*)(cbf + m32 * 72 + kk * 16 + hi * 8);
        const bf16x8 bb = *(const bf16x8*)(h0b + (p0 + m32) * 72 + kk * 16 + hi * 8);
        acc = MFMA32(a, bb, acc);
      }
#pragma unroll
      for (int r = 0; r < 16; r++) acc[r] *= eal[crow32(r, hi)];
#pragma unroll
      for (int jj = 0; jj < 2; jj++) {
        const bf16x8 a = *(const bf16x8*)(mysc + m32 * 40 + jj * 16 + hi * 8);
        const bf16x8 bb = *(const bf16x8*)(xT + (p0 + m32) * 40 + jj * 16 + hi * 8);
        acc = MFMA32(a, bb, acc);
      }
#pragma unroll
      for (int r = 0; r < 16; r++) {
        const int i = crow32(r, hi);
        ol[i * 64 + p0 + m32] = acc[r] + Dh * xl[i * 64 + p0 + m32];
      }
    }
    __syncthreads();
    scan_out(ol, bufy, row0, ts, dir, t8, h * 64, c >= (nc >> 1), yprev);
    if (c == (nc >> 1) - 1) { __threadfence(); __syncthreads(); }
  }
  if (!lat) {
    float* dst = p.out + O_SSM + ((((size_t)b * 2 + l) * 2 + dir) * 8 + h) * 4096;
#pragma unroll
    for (int r = 0; r < 16; r++) dst[(pt * 32 + crow32(r, hi)) * 64 + nt * 32 + m32] = Hacc[r];
  }
}

__device__ __forceinline__ void lru_unit(const Params& p, int l, int seq, int k, char* lds) {
  const int tid = tid_(), dir = tid >> 8, t8 = tid & 255;
  const bool lat = seq >= 16;
  const int b = lat ? seq - 16 : seq, T = lat ? 2048 : 256, row0 = lat ? NCTX + b * 2048 : b * 256;
  char* dbase = lds + dir * 59776;
  bfu* wT = (bfu*)dbase;
  float* xl = (float*)(dbase + 18432);
  bfu* xb = (bfu*)(dbase + 26624);
  float* gl = (float*)(dbase + 31232);
  float* ol = (float*)(dbase + 47616);
  float* cA = (float*)(dbase + 55808), *cU = (float*)(dbase + 56832), *carry = (float*)(dbase + 57856);
  float* cwl = (float*)(dbase + 58112);
  const bfu* proj = ws_bf(p, WS_PROJ);
  bfu* bufy = ws_bf(p, WS_BUFY) + (size_t)2 * NTOK * 512;
  const int e = t8 & 63, tq = t8 >> 6;
  const int s_ld = t8 >> 3, dc = t8 & 7;
  const int wv = t8 >> 6, lane = t8 & 63, m32 = lane & 31, hi = lane >> 5;
  __syncthreads();
  {
    const float* wa = p.in[I_LWA] + (size_t)((l * 2 + dir) * 8 + k) * 4096;
    const float* wi = p.in[I_LWI] + (size_t)((l * 2 + dir) * 8 + k) * 4096;
    for (int i = t8; i < 4096; i += 256) {
      const int d = i >> 6, ee = i & 63;
      wT[ee * 72 + d] = f2bf(wa[i]);
      wT[(64 + ee) * 72 + d] = f2bf(wi[i]);
    }
    if (t8 < 64) carry[t8] = lat ? p.in[I_SLRU][(((size_t)b * 2 + l) * 2 + dir) * 512 + k * 64 + t8] : 0.f;
    const float* cw = p.in[I_LCW] + (size_t)l * 4 * 512;
    const float* cb = p.in[I_LCB] + (size_t)l * 512;
    for (int i = t8; i < 320; i += 256) {
      int j = i >> 6, d = i & 63;
      cwl[i] = (j < 4) ? cw[j * 512 + k * 64 + d] : cb[k * 64 + d];
    }
  }
  const int ecol = wv * 32 + m32;
  const float gbias = (ecol < 64) ? p.in[I_LBA][(l * 2 + dir) * 512 + k * 64 + ecol]
                                  : p.in[I_LBI][(l * 2 + dir) * 512 + k * 64 + (ecol - 64)];
  const float sp = softplusf_(-p.in[I_LLAM][(l * 2 + dir) * 512 + k * 64 + e]);
  const int nc = T >> 5;
  uint4 raw[4];
  {
    const int ts = (dir ? nc - 1 : 0) << 5;
    const int tt = dir ? ts + 31 - s_ld : ts + s_ld;
    load_taps(proj, row0, T, tt, C_XD + k * 64 + dc * 8, raw);
  }
  __syncthreads();
  for (int c = 0; c < nc; c++) {
    const int ts = (dir ? nc - 1 - c : c) << 5;
    const uint4 yprev = scan_prev(bufy, row0, ts, dir, t8, k * 64, c >= (nc >> 1));
    {
      float o[8];
      conv_lds(raw, cwl, dc, o);
      float* dst = xl + s_ld * 64 + dc * 8;
      *(float4*)dst = make_float4(o[0], o[1], o[2], o[3]);
      *(float4*)(dst + 4) = make_float4(o[4], o[5], o[6], o[7]);
      *(uint4*)(xb + s_ld * 72 + dc * 8) = pack8(o);
    }
    __syncthreads();
    if (c + 1 < nc) {
      const int ts2 = (dir ? nc - 2 - c : c + 1) << 5;
      const int tt = dir ? ts2 + 31 - s_ld : ts2 + s_ld;
      load_taps(proj, row0, T, tt, C_XD + k * 64 + dc * 8, raw);
    }
    {
      f32x16 acc;
#pragma unroll
      for (int r = 0; r < 16; r++) acc[r] = 0.f;
#pragma unroll
      for (int kk = 0; kk < 4; kk++) {
        const bf16x8 a = *(const bf16x8*)(xb + m32 * 72 + kk * 16 + hi * 8);
        const bf16x8 bb = *(const bf16x8*)(wT + ecol * 72 + kk * 16 + hi * 8);
        acc = MFMA32(a, bb, acc);
      }
#pragma unroll
      for (int r = 0; r < 16; r++) gl[crow32(r, hi) * 128 + ecol] = sigmoidf_(acc[r] + gbias);
    }
    __syncthreads();
    float av[8], uv[8];
    float Ac = 1.f, Uc = 0.f;
#pragma unroll
    for (int i = 0; i < 8; i++) {
      const int s = tq * 8 + i;
      const float r = gl[s * 128 + e], ig = gl[s * 128 + 64 + e];
      float la = -8.f * r * sp;
      float a = __expf(la);
      float u = sqrtf(fmaxf(1.f - a * a, 0.f)) * ig * xl[s * 64 + e];
      av[i] = a; uv[i] = u;
      Uc = a * Uc + u;
      Ac *= a;
    }
    cA[tq * 64 + e] = Ac;
    cU[tq * 64 + e] = Uc;
    __syncthreads();
    float hh = carry[e];
    for (int q = 0; q < tq; q++) hh = cA[q * 64 + e] * hh + cU[q * 64 + e];
#pragma unroll
    for (int i = 0; i < 8; i++) {
      hh = av[i] * hh + uv[i];
      ol[(tq * 8 + i) * 64 + e] = hh;
    }
    __syncthreads();
    if (tq == 3) carry[e] = hh;
    scan_out(ol, bufy, row0, ts, dir, t8, k * 64, c >= (nc >> 1), yprev);
    if (c == (nc >> 1) - 1) { __threadfence(); __syncthreads(); }
  }
  __syncthreads();
  if (!lat && t8 < 64) p.out[O_LRU + (((size_t)b * 2 + l) * 2 + dir) * 512 + k * 64 + t8] = carry[t8];
}


__device__ __forceinline__ void attn_tile(const char* Kl, const bfu* Vt, int lane, int lq, int sw, const bf16x8 (&qf)[2],
                                          f32x4 (&O)[4], float& m, float& lsum) {
    f32x4 sc[4];
#pragma unroll
    for (int st = 0; st < 4; st++) {
      sc[st] = f32x4{0.f, 0.f, 0.f, 0.f};
#pragma unroll
      for (int s = 0; s < 2; s++) {
        bf16x8 kf = *(const bf16x8*)(Kl + (st * 16 + (lane & 15)) * 128 + (((s * 4 + lq) ^ sw) << 4));
        sc[st] = __builtin_amdgcn_mfma_f32_16x16x32_bf16(kf, qf[s], sc[st], 0, 0, 0);
      }
    }
    float mx = -1e30f;
#pragma unroll
    for (int st = 0; st < 4; st++)
#pragma unroll
      for (int j = 0; j < 4; j++) { sc[st][j] *= 0.125f; mx = fmaxf(mx, sc[st][j]); }
    mx = fmaxf(mx, __shfl_xor(mx, 16, 64));
    mx = fmaxf(mx, __shfl_xor(mx, 32, 64));
    const float mn = fmaxf(m, mx);
    const float corr = __expf(m - mn);
    m = mn;
    lsum *= corr;
#pragma unroll
    for (int i = 0; i < 4; i++)
#pragma unroll
      for (int j = 0; j < 4; j++) O[i][j] *= corr;
    float ps = 0.f;
#pragma unroll
    for (int st = 0; st < 4; st++)
#pragma unroll
      for (int j = 0; j < 4; j++) { sc[st][j] = __expf(sc[st][j] - mn); ps += sc[st][j]; }
    lsum += ps;
#pragma unroll
    for (int s2 = 0; s2 < 2; s2++) {
      union { uint4 u; bf16x8 v; } pf;
      pf.u.x = pack2(sc[2 * s2][0], sc[2 * s2][1]); pf.u.y = pack2(sc[2 * s2][2], sc[2 * s2][3]);
      pf.u.z = pack2(sc[2 * s2 + 1][0], sc[2 * s2 + 1][1]); pf.u.w = pack2(sc[2 * s2 + 1][2], sc[2 * s2 + 1][3]);
#pragma unroll
      for (int ds = 0; ds < 4; ds++) {
        const bfu* vr = Vt + (ds * 16 + (lane & 15)) * 68;
        union { uint2 u2[2]; bf16x8 v; } vf;
        vf.u2[0] = *(const uint2*)(vr + (2 * s2) * 16 + lq * 4);
        vf.u2[1] = *(const uint2*)(vr + (2 * s2 + 1) * 16 + lq * 4);
        O[ds] = __builtin_amdgcn_mfma_f32_16x16x32_bf16(vf.v, pf.v, O[ds], 0, 0, 0);
      }
    }
}

__device__ __forceinline__ void attn_unit(const Params& p, int l, int lat, int b, int h, int qb, char* lds, bool dry) {
  const int tid = tid_(), lane = tid & 63, w = tid >> 6;
  const int T = lat ? 2048 : 256, row0 = lat ? NCTX + b * 2048 : b * 256;
  const int kvh = h >> 2;
  const int nkt = lat ? 36 : 4;
  bfu* proj = ws_bf(p, WS_PROJ);
  char* Kl = lds;
  bfu* Vt = (bfu*)(lds + 8192);
  const int qrow = row0 + qb * 128 + w * 16 + (lane & 15);
  const int lq = lane >> 4;
  bf16x8 qf[2];
  qf[0] = *(const bf16x8*)(proj + (size_t)qrow * LDP + C_QB + h * 64 + lq * 8);
  qf[1] = *(const bf16x8*)(proj + (size_t)qrow * LDP + C_QB + h * 64 + 32 + lq * 8);
  f32x4 O[4];
#pragma unroll
  for (int i = 0; i < 4; i++) O[i] = f32x4{0.f, 0.f, 0.f, 0.f};
  float m = -1e30f, lsum = 0.f;
  const int key = tid >> 3, ch = tid & 7;
  const int sw = (lane & 15) >> 1;
  u32x4 rkA, rvA, rkB, rvB;
#define ATT_LOAD(RK, RV, KT)                                                                              \
  {                                                                                                       \
    const int kt_ = (KT);                                                                                 \
    if (lat && kt_ < 4) {                                                                                 \
      size_t idx = ((((size_t)b * 2 + l) * 256 + kt_ * 64 + key) * 2 + kvh) * 64 + ch * 8;               \
      const float* ck = p.in[I_CK] + idx;                                                                 \
      const float* cv = p.in[I_CV] + idx;                                                                 \
      float4 a0 = *(const float4*)ck, a1 = *(const float4*)(ck + 4);                                      \
      float4 b0 = *(const float4*)cv, b1 = *(const float4*)(cv + 4);                                      \
      RK = u32x4{pack2(a0.x, a0.y), pack2(a0.z, a0.w), pack2(a1.x, a1.y), pack2(a1.z, a1.w)};            \
      RV = u32x4{pack2(b0.x, b0.y), pack2(b0.z, b0.w), pack2(b1.x, b1.y), pack2(b1.z, b1.w)};            \
    } else {                                                                                              \
      int tk = (kt_ - (lat ? 4 : 0)) * 64 + key;                                                          \
      const bfu* pr = proj + (size_t)(row0 + tk) * LDP;                                                   \
      RK = *(const u32x4*)(pr + C_KB + kvh * 64 + ch * 8);                                                \
      RV = *(const u32x4*)(pr + C_VB + kvh * 64 + ch * 8);                                                \
    }                                                                                                     \
  }
#define ATT_STEP(RK, RV, KT)                                                                              \
  {                                                                                                       \
    *(u32x4*)(Kl + key * 128 + ((ch ^ ((key >> 1) & 7)) << 4)) = RK;                                     \
    {                                                                                                     \
      bfu* vd = Vt + (ch * 8) * 68 + key;                                                                 \
      vd[0 * 68] = (bfu)(RV.x & 0xffff); vd[1 * 68] = (bfu)(RV.x >> 16);                                  \
      vd[2 * 68] = (bfu)(RV.y & 0xffff); vd[3 * 68] = (bfu)(RV.y >> 16);                                  \
      vd[4 * 68] = (bfu)(RV.z & 0xffff); vd[5 * 68] = (bfu)(RV.z >> 16);                                  \
      vd[6 * 68] = (bfu)(RV.w & 0xffff); vd[7 * 68] = (bfu)(RV.w >> 16);                                  \
    }                                                                                                     \
    __syncthreads();                                                                                      \
    if ((KT) + 2 < nkt) ATT_LOAD(RK, RV, (KT) + 2);                                                       \
    attn_tile(Kl, Vt, lane, lq, sw, qf, O, m, lsum);                                                      \
    __syncthreads();                                                                                      \
  }
  __syncthreads();
  ATT_LOAD(rkA, rvA, 0);
  ATT_LOAD(rkB, rvB, 1);
  for (int kt = 0; kt < nkt; kt += 2) {
    ATT_STEP(rkA, rvA, kt);
    ATT_STEP(rkB, rvB, kt + 1);
  }
#undef ATT_LOAD
#undef ATT_STEP
  lsum += __shfl_xor(lsum, 16, 64);
  lsum += __shfl_xor(lsum, 32, 64);
  const float inv = 1.f / lsum;
  if (!dry || lsum < 0.f)
#pragma unroll
  for (int ds = 0; ds < 4; ds++) {
    uint2 pk;
    pk.x = pack2(O[ds][0] * inv, O[ds][1] * inv);
    pk.y = pack2(O[ds][2] * inv, O[ds][3] * inv);
    *(uint2*)(proj + (size_t)qrow * LDP + C_QB + h * 64 + ds * 16 + lq * 4) = pk;
  }
}

__device__ __forceinline__ void phase_mixers(const Params& p, int l, char* lds, int rep) {
  __shared__ int s_unit;
  {
  int* ctr = (int*)(p.ws + WS_CTR) + l + 2 * rep;
  const int NU = (rep == 1 || rep >= 4) ? 576 : 1856;
  const bool dry_ = rep >= 2;
  while (true) {
    __syncthreads();
    if (tid_() == 0) s_unit = atomicAdd(ctr, 1);
    __syncthreads();
    const int u = s_unit + (rep == 2 ? 576 : 0);
    if (u >= NU) break;
    if (rep >= 4) {
      const int typ = (u < 64) ? 0 : (u < 128) ? 1 : (u < 192) ? 2 : (u < 320) ? 0 : (u < 448) ? 1 : 2;
      if (typ != rep - 4) continue;
    }
    if (u < 64) delta_unit(p, l, 16 + (u >> 3), u & 7, lds);
    else if (u < 128) ssd_unit(p, l, 16 + ((u - 64) >> 3), (u - 64) & 7, lds);
    else if (u < 192) lru_unit(p, l, 16 + ((u - 128) >> 3), (u - 128) & 7, lds);
    else if (u < 320) delta_unit(p, l, (u - 192) >> 3, (u - 192) & 7, lds);
    else if (u < 448) ssd_unit(p, l, (u - 320) >> 3, (u - 320) & 7, lds);
    else if (u < 576) lru_unit(p, l, (u - 448) >> 3, (u - 448) & 7, lds);
    else if (u < 1600) { int a = u - 576; attn_unit(p, l, 1, a >> 7, (a >> 4) & 7, a & 15, lds, dry_); }
    else { int a = u - 1600; attn_unit(p, l, 0, a >> 4, (a >> 1) & 7, a & 1, lds, dry_); }
  }
  }
}

__device__ __forceinline__ void phase_branch_norm(const Params& p, int l) {
  const int lane = tid_() & 63, w = tid_() >> 6;
  bfu* proj = ws_bf(p, WS_PROJ);
  const bfu* by = ws_bf(p, WS_BUFY);
  const int c0 = lane * 8;
  float gs[8], gd[8];
#pragma unroll
  for (int i = 0; i < 8; i++) { gs[i] = p.in[I_SNORM][l * 512 + c0 + i]; gd[i] = p.in[I_DNORM][l * 64 + ((c0 + i) & 63)]; }
  for (int row = blockIdx.x * 8 + w; row < NTOK; row += gridDim.x * 8) {
    bfu* pr = proj + (size_t)row * LDP;
    float y[8], z[8], o[8];
    unpack8(*(const uint4*)(by + (size_t)row * 512 + c0), y);
    unpack8(*(const uint4*)(pr + C_Z + c0), z);
    float ss = 0.f;
#pragma unroll
    for (int i = 0; i < 8; i++) { y[i] = y[i] * siluf_(z[i]); ss += y[i] * y[i]; }
    ss = wave_sum(ss);
    float r = rsqrtf(ss * (1.f / 512.f) + 1e-6f);
#pragma unroll
    for (int i = 0; i < 8; i++) o[i] = y[i] * r * gs[i];
    *(uint4*)(pr + C_Z + c0) = pack8(o);
    unpack8(*(const uint4*)(by + (size_t)(NTOK + row) * 512 + c0), y);
    unpack8(*(const uint4*)(pr + C_GC + c0), z);
    ss = 0.f;
#pragma unroll
    for (int i = 0; i < 8; i++) ss += y[i] * y[i];
    ss = DPP_ADD(ss, 0xB1); ss = DPP_ADD(ss, 0x4E); ss = DPP_ADD(ss, 0x141);
    r = rsqrtf(ss * (1.f / 64.f) + 1e-6f);
#pragma unroll
    for (int i = 0; i < 8; i++) o[i] = y[i] * r * gd[i] * siluf_(z[i]);
    *(uint4*)(pr + C_GC + c0) = pack8(o);
    unpack8(*(const uint4*)(by + (size_t)(2 * NTOK + row) * 512 + c0), y);
    unpack8(*(const uint4*)(pr + C_YD + c0), z);
#pragma unroll
    for (int i = 0; i < 8; i++) o[i] = y[i] * gelu_tanh(z[i]);
    *(uint4*)(pr + C_YD + c0) = pack8(o);
  }
}

constexpr int NPHASE = 28;

__device__ __forceinline__ void run_phase(const Params& p, int ph, char* lds) {
  if (ph == 0) {
    if (blockIdx.x == 0) { for (int i = tid_(); i < 1024; i += NTHREADS) ((int*)(p.ws + WS_CTR))[i] = 0; }
    phase_rope_table(p);
    phase_mods(p, lds);
  }
  if (ph == NPHASE - 1) { phase_final_norm(p); return; }
  const int l = (ph - 1) / 13, s = (ph == 0) ? 0 : (ph - 1) % 13;
  if (s == 0 || s == 3 || s == 10) {
    if (ph != 0) phase_norm(p, l, s == 0 ? 0 : (s == 3 ? 1 : 2), s == 0 && l == 0);
#ifdef REP_NORM
    if (ph != 0) { for (int r = 0; r < 2; r++) phase_norm(p, l, s == 0 ? 0 : (s == 3 ? 1 : 2), s == 0 && l == 0); }
#endif
    int jlo = 0, jhi = 0, cl = 1;
    if (ph == 0) { jlo = 0; jhi = 11; cl = 0; }
    if (s == 0 && l == 1) { jlo = 2; jhi = 11; }
    if (s == 3 && l == 0) { jlo = 0; jhi = 2; }
    if (jhi > jlo) { __syncthreads(); convert_jobs(p, cl, jlo, jhi, lds); }
  } else if (s == 1 || s == 11) {
    for (int r = 0; r < REP_GEMM; r++) phase_gemm_w13(p, s == 1 ? WS_W13A : WS_W13B, lds);
  } else if (s == 2 || s == 9 || s == 12) {
    const bfu* A = ws_bf(p, WS_PROJ) + (s == 9 ? C_MRG : 0);
    const int lda = (s == 9) ? LDP : DFF, K = (s == 9) ? 1024 : DFF;
    const size_t wo = (s == 2) ? WS_W2A : (s == 9 ? WS_WOUT : WS_W2B);
    const int midx = (s == 2) ? 2 : (s == 9 ? 5 : 8);
#ifdef REP_RES
    for (int r = 0; r < 2; r++)
    phase_gemm_res(p, l, A, lda, K, wo, midx, s == 9 ? 1.0f : 0.5f, s == 2 && l == 0, lds, r == 0);
#else
    phase_gemm_res(p, l, A, lda, K, wo, midx, s == 9 ? 1.0f : 0.5f, s == 2 && l == 0, lds);
#endif
  } else if (s == 4) { for (int r = 0; r < REP_GEMM; r++) phase_gemm_win(p, lds); }
  else if (s == 5) phase_prep(p, l);
  else if (s == 6) phase_mixers(p, l, lds, 0);
  else if (s == 7) phase_branch_norm(p, l);
  else if (s == 8) { for (int r = 0; r < REP_GEMM; r++) phase_gemm_merge(p, lds); }
}

#define XB_TMO      128
#define XB_XCNT(j)  (256  + 64 * (j))
#define XB_XSUB(j)  (1280 + 64 * (j))
#define XB_XGEN(j)  (2304 + 64 * (j))
#define XB_TOP      3328
#define XB_TOPGEN   3392
#define XCD_BAR_WORDS 3456
#define XB_SPIN_CAP (1u << 18)
#define LAS __attribute__((address_space(3)))

__device__ __forceinline__ unsigned xb_ld(unsigned* p)              { return __hip_atomic_load(p, __ATOMIC_RELAXED, __HIP_MEMORY_SCOPE_AGENT); }
__device__ __forceinline__ unsigned xb_add(unsigned* p, unsigned v) { return __hip_atomic_fetch_add(p, v, __ATOMIC_RELAXED, __HIP_MEMORY_SCOPE_AGENT); }
__device__ __forceinline__ unsigned xb_xcc_id() { return (unsigned)__builtin_amdgcn_s_getreg((3 << 11) | 20) & 0xFu; }
#define XB_SPIN(cond, bar) do { unsigned _sp = 0; while (cond) { __builtin_amdgcn_s_sleep(1); \
    if ((++_sp & 255u) == 0u) { if (xb_ld(&(bar)[XB_TMO])) break; if (_sp > XB_SPIN_CAP) { atomicAdd(&(bar)[XB_TMO], 1u); break; } } } } while (0)

struct XcdBarrier {
    unsigned* bar; unsigned x;
    volatile LAS unsigned* st;
};

__device__ __forceinline__ XcdBarrier xcd_barrier_post(unsigned* bar, volatile LAS unsigned* st) {
    XcdBarrier b; b.bar = bar; b.x = xb_xcc_id(); b.st = st;
    if (threadIdx.x == 0) (void)xb_add(&bar[XB_XCNT(b.x)], 1u);
    return b;
}
__device__ __forceinline__ void xcd_barrier_complete(unsigned* bar, unsigned x, unsigned& nloc, unsigned& nx) {
    const unsigned G = gridDim.x * gridDim.y * gridDim.z;
    unsigned sum, cnt, mine, sp = 0u;
    for (;;) {
        sum = 0u; cnt = 0u; mine = 0u;
#pragma unroll
        for (unsigned j = 0; j < 16; ++j) { const unsigned c = xb_ld(&bar[XB_XCNT(j)]); sum += c; cnt += (c > 0u) ? 1u : 0u; mine = (j == x) ? c : mine; }
        if (sum == G) break;
        __builtin_amdgcn_s_sleep(1);
        if ((++sp & 255u) == 0u) { if (xb_ld(&bar[XB_TMO])) break; if (sp > XB_SPIN_CAP) { atomicAdd(&bar[XB_TMO], 1u); break; } }
    }
    nloc = mine > 0u ? mine : 1u; nx = cnt > 0u ? cnt : 1u;
}

__device__ __forceinline__ void xcd_barrier(const XcdBarrier& b) {
    asm volatile("s_waitcnt vmcnt(0)" ::: "memory");
    __syncthreads();
    if (threadIdx.x == 0) {
        unsigned* bar = b.bar;
        __builtin_amdgcn_s_waitcnt(0);
        unsigned nloc = b.st[0], nx = b.st[1];
        if (nloc == 0u) { xcd_barrier_complete(bar, b.x, nloc, nx); b.st[0] = nloc; b.st[1] = nx; }
        const unsigned old = xb_add(&bar[XB_XSUB(b.x)], 1u);
        const unsigned gen = old / nloc;
        if (old + 1u == (gen + 1u) * nloc) {
            __builtin_amdgcn_fence(__ATOMIC_RELEASE, "agent");
            asm volatile("s_waitcnt vmcnt(0)" ::: "memory");
            const unsigned og = xb_add(&bar[XB_TOP], 1u);
            const unsigned tg = og / nx;
            if (og + 1u == (tg + 1u) * nx) xb_add(&bar[XB_TOPGEN], 1u);
            else XB_SPIN(xb_ld(&bar[XB_TOPGEN]) == tg, bar);
            __builtin_amdgcn_fence(__ATOMIC_ACQUIRE, "agent");
            xb_add(&bar[XB_XGEN(b.x)], 1u);
            asm volatile("s_waitcnt vmcnt(0)" ::: "memory");
        } else {
            XB_SPIN(xb_ld(&bar[XB_XGEN(b.x)]) == gen, bar);
            __builtin_amdgcn_fence(__ATOMIC_ACQUIRE, "agent");
            asm volatile("s_waitcnt vmcnt(0)" ::: "memory");
        }
    }
    __syncthreads();
}


__device__ __forceinline__ void gbar(unsigned* bar, unsigned k) {
  asm volatile("s_waitcnt vmcnt(0)" ::: "memory");
  __syncthreads();
  if (threadIdx.x == 0) {
    __builtin_amdgcn_fence(__ATOMIC_RELEASE, "agent");
    asm volatile("s_waitcnt vmcnt(0)" ::: "memory");
    const unsigned g = blockIdx.x & 7u;
    const unsigned ng = (gridDim.x - g + 7u) >> 3;
    const unsigned old = __hip_atomic_fetch_add(bar + g * 64, 1u, __ATOMIC_RELAXED, __HIP_MEMORY_SCOPE_AGENT);
    if (old + 1u == k * ng) {
      const unsigned ngroups = gridDim.x < 8u ? gridDim.x : 8u;
      const unsigned o2 = __hip_atomic_fetch_add(bar + 8 * 64, 1u, __ATOMIC_RELAXED, __HIP_MEMORY_SCOPE_AGENT);
      if (o2 + 1u == k * ngroups) __hip_atomic_fetch_add(bar + 9 * 64, 1u, __ATOMIC_RELAXED, __HIP_MEMORY_SCOPE_AGENT);
    }
    while (__hip_atomic_load(bar + 9 * 64, __ATOMIC_RELAXED, __HIP_MEMORY_SCOPE_AGENT) < k) __builtin_amdgcn_s_sleep(1);
    __builtin_amdgcn_fence(__ATOMIC_ACQUIRE, "agent");
    asm volatile("s_waitcnt vmcnt(0)" ::: "memory");
  }
  __syncthreads();
}

__global__ void __launch_bounds__(NTHREADS) mega(Params p, int ph_lo, int ph_hi) {
  extern __shared__ __attribute__((aligned(16))) char lds[];
  cg::grid_group grid = cg::this_grid();
  __shared__ uint4 xb_words;
  if (threadIdx.x == 0) xb_words = make_uint4(0u, 0u, 0u, 0u);
  __syncthreads();
  const XcdBarrier xb = xcd_barrier_post((unsigned*)(p.ws + WS_XBAR), (volatile LAS unsigned*)&xb_words);
  for (int ph = ph_lo; ph < ph_hi; ph++) {
    run_phase(p, ph, lds);
#ifdef REP_P0
    if (ph == 0) { __syncthreads(); run_phase(p, ph, lds); }
#endif
#ifdef REP_TYPE
    if (ph >= 1 && ph < NPHASE - 1 && (ph - 1) % 13 == 6) { grid.sync(); phase_mixers(p, (ph - 1) / 13, lds, 4 + REP_TYPE); }
#endif
#ifdef REP_MIX
    if (ph >= 1 && ph < NPHASE - 1 && (ph - 1) % 13 == 6) { grid.sync(); phase_mixers(p, (ph - 1) / 13, lds, 3); }
#endif
#ifdef REP_ATTN
    if (ph >= 1 && ph < NPHASE - 1 && (ph - 1) % 13 == 6) { grid.sync(); phase_mixers(p, (ph - 1) / 13, lds, 2); }
#endif
#if REP_SCAN > 1
    if (ph >= 1 && ph < NPHASE - 1 && (ph - 1) % 13 == 6) { grid.sync(); phase_mixers(p, (ph - 1) / 13, lds, 1); }
#endif
    if (ph + 1 < ph_hi) {
      if (ph_hi < 0) grid.sync();
      xcd_barrier(xb);
    }
  }
}

extern "C" void kernel_launch(void* const* d_in, const int* in_sizes, int n_in, void* d_out, int out_size, void* d_ws,
                              size_t ws_size, hipStream_t stream) {
  static int grid_blocks = 0;
  if (grid_blocks == 0) {
    if (n_in != 42 || ws_size < WS_END) {
      fprintf(stderr, "kernel_launch: unexpected n_in %d or ws_size %zu (need %zu)\n", n_in, ws_size, (size_t)WS_END);
      grid_blocks = -1;
      return;
    }
    int dev = 0, cus = 0, per_cu = 0;
    (void)hipGetDevice(&dev);
    (void)hipDeviceGetAttribute(&cus, hipDeviceAttributeMultiprocessorCount, dev);
    (void)hipFuncSetAttribute((const void*)mega, hipFuncAttributeMaxDynamicSharedMemorySize, LDS_BYTES);
    (void)hipOccupancyMaxActiveBlocksPerMultiprocessor(&per_cu, (const void*)mega, NTHREADS, LDS_BYTES);
    if (per_cu < 1) { fprintf(stderr, "kernel_launch: occupancy query returned %d\n", per_cu); per_cu = 1; }
    grid_blocks = cus;
  }
  if (grid_blocks < 0) return;
  Params p{};
  for (int i = 0; i < 42; i++) p.in[i] = (const float*)d_in[i];
  p.out = (float*)d_out;
  p.ws = (char*)d_ws;
  (void)hipMemsetAsync((char*)d_ws + WS_XBAR, 0, XCD_BAR_WORDS * sizeof(unsigned), stream);
  int lo = 0, hi = NPHASE;
  void* args[] = {&p, &lo, &hi};
  hipError_t e = hipLaunchCooperativeKernel((const void*)mega, dim3(grid_blocks), dim3(NTHREADS), args, LDS_BYTES, stream);
  if (e != hipSuccess) fprintf(stderr, "cooperative launch failed: %s (grid %d)\n", hipGetErrorString(e), grid_blocks);
}

#ifdef RES_TEST
#define TK(name, body) __global__ void __launch_bounds__(NTHREADS) name(Params p, int l) { extern __shared__ __attribute__((aligned(16))) char lds[]; body; }
TK(t_mods, phase_mods(p, lds))
TK(t_cvt, convert_jobs(p, l, 0, 11, lds))
TK(t_norm, phase_norm(p, l, 0, l == 0))
TK(t_w13, phase_gemm_w13(p, WS_W13A, lds))
TK(t_res, phase_gemm_res(p, l, ws_bf(p, WS_PROJ), DFF, DFF, WS_W2A, 2, 0.5f, l == 0, lds))
TK(t_win, phase_gemm_win(p, lds))
TK(t_prep, phase_prep(p, l))
TK(t_delta, delta_unit(p, l, l, 3, lds))
TK(t_ssd, ssd_unit(p, l, l, 3, lds))
TK(t_lru, lru_unit(p, l, l, 3, lds))
TK(t_attn, attn_unit(p, l, l & 1, 2, 3, 1, lds, false))
TK(t_bn, phase_branch_norm(p, l))
TK(t_merge, phase_gemm_merge(p, lds))
#endif
```
